# Optimizing an MI355X kernel written in HIP

```python
import math
import jax
import jax.numpy as jnp
from jax import lax
import numpy as np

D_MODEL = 1024
BATCH = 4
SEQ = 8192
DEPTH = 2

BLOCK_Q = 128
EPS = 1e-6
NEG = -1e30
D_FF = 2816

MLA_HEADS = 8
MLA_Q_RANK = 256
MLA_KV_RANK = 128
MLA_NOPE = 64
MLA_ROPE = 32
MLA_V = 64
ROPE_THETA = 10000.0

SWA_HEADS = 8
SWA_KV_HEADS = 2
SWA_HD = 64
SWA_WINDOW = 128

NSA_HEADS = 8
NSA_KV_HEADS = 2
NSA_HD = 64
NSA_CMP_LEN = 32
NSA_CMP_STRIDE = 16
NSA_CMP_HIDDEN = 128
NSA_SEL_LEN = 64
NSA_TOPK = 16
NSA_WINDOW = 512
NSA_FORCE = 1e4

DIFF_HEADS = 4
DIFF_HD = 64

N_BUCKETS = 32
MAX_DIST = 128
N_BIAS_HEADS = SWA_HEADS + NSA_HEADS + DIFF_HEADS

N_BRANCH = 4
BRANCH_W = 512

COL_SIZES = (
    MLA_Q_RANK, MLA_KV_RANK, MLA_ROPE,
    SWA_HEADS * SWA_HD, SWA_KV_HEADS * SWA_HD, SWA_KV_HEADS * SWA_HD,
    NSA_HEADS * NSA_HD,
    NSA_KV_HEADS * NSA_HD, NSA_KV_HEADS * NSA_HD,
    NSA_KV_HEADS * NSA_HD, NSA_KV_HEADS * NSA_HD,
    NSA_KV_HEADS * NSA_HD, NSA_KV_HEADS * NSA_HD,
    3 * NSA_HEADS,
    DIFF_HEADS * 2 * DIFF_HD, DIFF_HEADS * 2 * DIFF_HD, DIFF_HEADS * 2 * DIFF_HD,
)
IN_COLS = sum(COL_SIZES)

kernel_name = 'hybrid_mla_swa_nsa_diff_block'


def rmsnorm(x, g):
    xf = x.astype(jnp.float32)
    y = xf * lax.rsqrt(jnp.mean(xf * xf, -1, keepdims=True) + EPS)
    return (y * g.astype(jnp.float32)).astype(x.dtype)


def swiglu(x, w_gate, w_up, w_down):
    return (jax.nn.silu(x @ w_gate) * (x @ w_up)) @ w_down


def rope(x, pos):
    half = x.shape[-1] // 2
    freqs = ROPE_THETA ** (-jnp.arange(half, dtype=jnp.float32) / half)
    ang = pos[:, None].astype(jnp.float32) * freqs
    cos, sin = jnp.cos(ang), jnp.sin(ang)
    xf = x.astype(jnp.float32)
    x1, x2 = xf[..., :half], xf[..., half:]
    return jnp.concatenate([x1 * cos - x2 * sin, x1 * sin + x2 * cos], -1).astype(x.dtype)


def t5_bucket(dist):
    n = jnp.maximum(dist, 0)
    max_exact = N_BUCKETS // 2
    nf = jnp.maximum(n, 1).astype(jnp.float32)
    large = max_exact + (jnp.log(nf / max_exact) / math.log(MAX_DIST / max_exact)
                         * (N_BUCKETS - max_exact)).astype(jnp.int32)
    large = jnp.minimum(large, N_BUCKETS - 1)
    return jnp.where(n < max_exact, n, large)


def rel_bias(table, q_pos, k_pos):
    b = t5_bucket(q_pos[:, None] - k_pos[None, :])
    return jnp.moveaxis(table[b], -1, 0).astype(jnp.float32)


def masked_softmax(s, mask):
    s = jnp.where(mask, s, NEG)
    m = jnp.max(s, -1, keepdims=True)
    e = jnp.where(mask, jnp.exp(s - m), 0.0)
    den = jnp.sum(e, -1, keepdims=True)
    return e / jnp.where(den > 0, den, 1.0)


def dense_causal_attn(q, k, v, scale):
    B, H, S, _ = q.shape
    dv = v.shape[-1]
    kpos = jnp.arange(S)

    def blk(i):
        start = i * BLOCK_Q
        qpos = start + jnp.arange(BLOCK_Q)
        qb = lax.dynamic_slice_in_dim(q, start, BLOCK_Q, axis=2)
        s = jnp.einsum('bhqd,bhkd->bhqk', qb, k).astype(jnp.float32) * scale
        s = jnp.where(kpos[None, :] <= qpos[:, None], s, NEG)
        p = jax.nn.softmax(s, -1)
        return jnp.einsum('bhqk,bhkd->bhqd', p.astype(v.dtype), v)

    o = lax.map(blk, jnp.arange(S // BLOCK_Q))
    return o.transpose(1, 0, 3, 2, 4).reshape(B, S, H * dv)


def banded_attn(q, k, v, window, table, sinks):
    B, Hkv, G, S, d = q.shape
    dv = v.shape[-1]
    nprev = -(-window // BLOCK_Q)
    pad = nprev * BLOCK_Q
    span = pad + BLOCK_Q
    kp = jnp.pad(k, ((0, 0), (0, 0), (pad, 0), (0, 0)))
    vp = jnp.pad(v, ((0, 0), (0, 0), (pad, 0), (0, 0)))
    scale = d ** -0.5

    def blk(i):
        start = i * BLOCK_Q
        qpos = start + jnp.arange(BLOCK_Q)
        kpos = start - pad + jnp.arange(span)
        qb = lax.dynamic_slice_in_dim(q, start, BLOCK_Q, axis=3)
        kb = lax.dynamic_slice_in_dim(kp, start, span, axis=2)
        vb = lax.dynamic_slice_in_dim(vp, start, span, axis=2)
        s = jnp.einsum('bhgqd,bhkd->bhgqk', qb, kb).astype(jnp.float32) * scale
        s = s + rel_bias(table, qpos, kpos).reshape(Hkv, G, BLOCK_Q, span)
        dist = qpos[:, None] - kpos[None, :]
        mask = (dist >= 0) & (dist < window) & (kpos[None, :] >= 0)
        s = jnp.where(mask, s, NEG)
        if sinks is None:
            p = jax.nn.softmax(s, -1)
        else:
            sk = sinks.astype(jnp.float32).reshape(Hkv, G, 1, 1)
            m = jnp.maximum(jnp.max(s, -1, keepdims=True), sk)
            e = jnp.exp(s - m)
            p = e / (jnp.sum(e, -1, keepdims=True) + jnp.exp(sk - m))
        return jnp.einsum('bhgqk,bhkd->bhgqd', p.astype(vb.dtype), vb)

    o = lax.map(blk, jnp.arange(S // BLOCK_Q))
    return jnp.moveaxis(o, 0, 3).reshape(B, Hkv, G, S, dv)


def mla_mixer(cq, ckv, k_rope, q_norm, kv_norm, w_uq, w_ukv, pos):
    B, S, _ = cq.shape
    H = MLA_HEADS
    q = (rmsnorm(cq, q_norm) @ w_uq).reshape(B, S, H, MLA_NOPE + MLA_ROPE).transpose(0, 2, 1, 3)
    q = jnp.concatenate([q[..., :MLA_NOPE], rope(q[..., MLA_NOPE:], pos)], -1)
    kv = (rmsnorm(ckv, kv_norm) @ w_ukv).reshape(B, S, H, MLA_NOPE + MLA_V).transpose(0, 2, 1, 3)
    k_r = jnp.broadcast_to(rope(k_rope[:, None], pos), (B, H, S, MLA_ROPE))
    k = jnp.concatenate([kv[..., :MLA_NOPE], k_r], -1)
    v = kv[..., MLA_NOPE:]
    return dense_causal_attn(q, k, v, (MLA_NOPE + MLA_ROPE) ** -0.5)


def swa_mixer(q, k, v, sinks, table):
    B, S, _ = q.shape
    G = SWA_HEADS // SWA_KV_HEADS
    q = q.reshape(B, S, SWA_KV_HEADS, G, SWA_HD).transpose(0, 2, 3, 1, 4)
    k = k.reshape(B, S, SWA_KV_HEADS, SWA_HD).transpose(0, 2, 1, 3)
    v = v.reshape(B, S, SWA_KV_HEADS, SWA_HD).transpose(0, 2, 1, 3)
    o = banded_attn(q, k, v, SWA_WINDOW, table, sinks)
    return o.transpose(0, 3, 1, 2, 4).reshape(B, S, SWA_HEADS * SWA_HD)


def nsa_compress(t, pos_emb, w1, w2):
    B, Hkv, S, d = t.shape
    nc = (S - NSA_CMP_LEN) // NSA_CMP_STRIDE + 1
    idx = np.arange(nc)[:, None] * NSA_CMP_STRIDE + np.arange(NSA_CMP_LEN)[None, :]
    blocks = jnp.take(t, jnp.asarray(idx, dtype=jnp.int32), axis=2) + pos_emb
    hdn = jax.nn.gelu(blocks.reshape(B, Hkv, nc, NSA_CMP_LEN * d) @ w1)
    return hdn @ w2


def nsa_mixer(q, kc, vc, ks, vs, kw, vw, gate_logits, cmp_pos, cmp_w1, cmp_w2, table):
    B, S, _ = q.shape
    Hkv, G, d = NSA_KV_HEADS, NSA_HEADS // NSA_KV_HEADS, NSA_HD
    SEL = NSA_SEL_LEN
    q = q.reshape(B, S, Hkv, G, d).transpose(0, 2, 3, 1, 4)

    def heads(t):
        return t.reshape(B, S, Hkv, d).transpose(0, 2, 1, 3)

    kc, vc, ks, vs, kw, vw = heads(kc), heads(vc), heads(ks), heads(vs), heads(kw), heads(vw)
    scale = d ** -0.5
    kcmp = nsa_compress(kc, cmp_pos[0], cmp_w1[0], cmp_w2[0])
    vcmp = nsa_compress(vc, cmp_pos[1], cmp_w1[1], cmp_w2[1])
    nc = kcmp.shape[2]
    c_start = np.arange(nc) * NSA_CMP_STRIDE
    c_last = jnp.asarray(c_start + NSA_CMP_LEN - 1, dtype=jnp.int32)
    nsel = S // SEL
    s_start = np.arange(nsel) * SEL
    overlap = jnp.asarray(((c_start[:, None] < s_start[None, :] + SEL)
                           & (s_start[None, :] < c_start[:, None] + NSA_CMP_LEN)).astype(np.float32))
    topk = min(NSA_TOPK, nsel)
    ksb = ks.reshape(B, Hkv, nsel, SEL, d)
    vsb = vs.reshape(B, Hkv, nsel, SEL, d)
    tab = table.reshape(N_BUCKETS, Hkv, G)
    gather = jax.vmap(jax.vmap(lambda blocks, ix: blocks[ix]))
    group_bias = jax.vmap(lambda bk, tb: tb[bk], in_axes=(1, 1), out_axes=1)
    sel_ids = jnp.arange(nsel)

    def blk(i):
        start = i * BLOCK_Q
        qpos = start + jnp.arange(BLOCK_Q)
        qb = lax.dynamic_slice_in_dim(q, start, BLOCK_Q, axis=3)
        s_c = jnp.einsum('bhgqd,bhcd->bhgqc', qb, kcmp).astype(jnp.float32) * scale
        p_c = masked_softmax(s_c, c_last[None, :] <= qpos[:, None])
        o_c = jnp.einsum('bhgqc,bhcd->bhgqd', p_c.astype(vcmp.dtype), vcmp)
        imp = jnp.einsum('bhgqc,cn->bhqn', p_c, overlap)
        cur = qpos // SEL
        causal = sel_ids[None, :] * SEL <= qpos[:, None]
        forced = ((sel_ids[None, :] == 0) | (sel_ids[None, :] == cur[:, None])
                  | (sel_ids[None, :] == cur[:, None] - 1))
        imp = jnp.where(causal, jnp.where(forced, NSA_FORCE, imp), -1.0)
        _, top = lax.top_k(imp, topk)
        k_sel = gather(ksb, top).reshape(B, Hkv, BLOCK_Q, topk * SEL, d)
        v_sel = gather(vsb, top).reshape(B, Hkv, BLOCK_Q, topk * SEL, d)
        kpos = (top[..., None] * SEL + jnp.arange(SEL)).reshape(B, Hkv, BLOCK_Q, topk * SEL)
        dist = qpos[:, None] - kpos
        bias = jnp.moveaxis(group_bias(t5_bucket(dist), tab), -1, 2).astype(jnp.float32)
        s_s = jnp.einsum('bhgqd,bhqkd->bhgqk', qb, k_sel).astype(jnp.float32) * scale + bias
        s_s = jnp.where((dist >= 0)[:, :, None], s_s, NEG)
        p_s = jax.nn.softmax(s_s, -1)
        o_s = jnp.einsum('bhgqk,bhqkd->bhgqd', p_s.astype(v_sel.dtype), v_sel)
        return o_c, o_s

    o_c, o_s = lax.map(blk, jnp.arange(S // BLOCK_Q))
    o_c = jnp.moveaxis(o_c, 0, 3).reshape(B, Hkv, G, S, d)
    o_s = jnp.moveaxis(o_s, 0, 3).reshape(B, Hkv, G, S, d)
    o_w = banded_attn(q, kw, vw, NSA_WINDOW, table, None)
    g = jax.nn.sigmoid(gate_logits.astype(jnp.float32)).reshape(B, S, Hkv, G, 3).transpose(0, 2, 3, 1, 4)
    o = g[..., 0:1] * o_c + g[..., 1:2] * o_s + g[..., 2:3] * o_w
    return o.astype(q.dtype).transpose(0, 3, 1, 2, 4).reshape(B, S, NSA_HEADS * d)


def diff_mixer(q, k, v, lam_params, subln, table, layer):
    B, S, _ = q.shape
    H, d = DIFF_HEADS, DIFF_HD
    q = q.reshape(B, S, H, 2, d).transpose(0, 2, 3, 1, 4)
    k = k.reshape(B, S, H, 2, d).transpose(0, 2, 3, 1, 4)
    v = v.reshape(B, S, H, 2 * d).transpose(0, 2, 1, 3)
    lam_init = 0.8 - 0.6 * math.exp(-0.3 * layer)
    lp = lam_params.astype(jnp.float32)
    lam = jnp.exp(jnp.sum(lp[0] * lp[1])) - jnp.exp(jnp.sum(lp[2] * lp[3])) + lam_init
    scale = d ** -0.5
    kpos = jnp.arange(S)

    def blk(i):
        start = i * BLOCK_Q
        qpos = start + jnp.arange(BLOCK_Q)
        qb = lax.dynamic_slice_in_dim(q, start, BLOCK_Q, axis=3)
        s = jnp.einsum('bhmqd,bhmkd->bhmqk', qb, k).astype(jnp.float32) * scale
        s = s + rel_bias(table, qpos, kpos)[:, None]
        s = jnp.where(kpos[None, :] <= qpos[:, None], s, NEG)
        p = jax.nn.softmax(s, -1)
        a = p[:, :, 0] - lam * p[:, :, 1]
        return jnp.einsum('bhqk,bhkd->bhqd', a.astype(v.dtype), v)

    o = lax.map(blk, jnp.arange(S // BLOCK_Q))
    o = jnp.moveaxis(o, 0, 2).reshape(B, H, S, 2 * d)
    o = rmsnorm(o, subln) * (1.0 - lam_init)
    return o.transpose(0, 2, 1, 3).reshape(B, S, H * 2 * d)


def setup_inputs(seed: int = 0) -> dict:
    key = jax.random.key(seed)
    k = jax.random.split(key, 22)
    f32 = jnp.float32

    def w(kk, shape, fan_in):
        return jax.random.normal(kk, shape, f32) * (fan_in ** -0.5)

    def gain(kk, shape):
        return 1.0 + 0.05 * jax.random.normal(kk, shape, f32)

    L, d = NSA_CMP_LEN, NSA_HD
    return {
        'x': jax.random.normal(k[0], (BATCH, SEQ, D_MODEL), f32),
        'norm_g': gain(k[1], (DEPTH, 3, D_MODEL)),
        'w_in': w(k[2], (DEPTH, D_MODEL, IN_COLS), D_MODEL),
        'mla_q_norm': gain(k[3], (DEPTH, MLA_Q_RANK)),
        'mla_kv_norm': gain(k[4], (DEPTH, MLA_KV_RANK)),
        'mla_w_uq': w(k[5], (DEPTH, MLA_Q_RANK, MLA_HEADS * (MLA_NOPE + MLA_ROPE)), MLA_Q_RANK),
        'mla_w_ukv': w(k[6], (DEPTH, MLA_KV_RANK, MLA_HEADS * (MLA_NOPE + MLA_V)), MLA_KV_RANK),
        'swa_sinks': 0.5 * jax.random.normal(k[7], (DEPTH, SWA_HEADS), f32),
        'nsa_cmp_pos': 0.1 * jax.random.normal(k[8], (DEPTH, 2, L, d), f32),
        'nsa_cmp_w1': w(k[9], (DEPTH, 2, L * d, NSA_CMP_HIDDEN), L * d),
        'nsa_cmp_w2': w(k[10], (DEPTH, 2, NSA_CMP_HIDDEN, d), NSA_CMP_HIDDEN),
        'diff_lambda': 0.1 * jax.random.normal(k[11], (DEPTH, 4, DIFF_HD), f32),
        'diff_subln': gain(k[12], (DEPTH, 2 * DIFF_HD)),
        'rel_bias_table': 0.2 * jax.random.normal(k[13], (N_BUCKETS, N_BIAS_HEADS), f32),
        'w_branch': w(k[14], (DEPTH, N_BRANCH, BRANCH_W, D_MODEL), BRANCH_W),
        'w_gate': w(k[15], (DEPTH, N_BRANCH, D_MODEL, D_MODEL), D_MODEL),
        'w_o': w(k[16], (DEPTH, D_MODEL, D_MODEL), D_MODEL),
        'ffn_w_gate': w(k[17], (DEPTH, 2, D_MODEL, D_FF), D_MODEL),
        'ffn_w_up': w(k[18], (DEPTH, 2, D_MODEL, D_FF), D_MODEL),
        'ffn_w_down': w(k[19], (DEPTH, 2, D_FF, D_MODEL), D_FF),
        'final_g': gain(k[20], (D_MODEL,)),
    }


def reference(x, norm_g, w_in, mla_q_norm, mla_kv_norm, mla_w_uq, mla_w_ukv, swa_sinks,
              nsa_cmp_pos, nsa_cmp_w1, nsa_cmp_w2, diff_lambda, diff_subln, rel_bias_table,
              w_branch, w_gate, w_o, ffn_w_gate, ffn_w_up, ffn_w_down, final_g):
    S = x.shape[1]
    pos = jnp.arange(S, dtype=jnp.int32)
    tab_swa = rel_bias_table[:, :SWA_HEADS]
    tab_nsa = rel_bias_table[:, SWA_HEADS:SWA_HEADS + NSA_HEADS]
    tab_diff = rel_bias_table[:, SWA_HEADS + NSA_HEADS:]
    offs = [int(o) for o in np.cumsum(COL_SIZES)[:-1]]
    h = x
    for l in range(DEPTH):
        h = h + 0.5 * swiglu(rmsnorm(h, norm_g[l, 0]), ffn_w_gate[l, 0], ffn_w_up[l, 0], ffn_w_down[l, 0])
        u = rmsnorm(h, norm_g[l, 1])
        cols = u @ w_in[l]
        (cq, ckv, krope, sq, sk, sv, nq, nkc, nvc, nks, nvs, nkw, nvw, ngate,
         dq, dk, dv) = jnp.split(cols, offs, axis=-1)
        y_a = mla_mixer(cq, ckv, krope, mla_q_norm[l], mla_kv_norm[l], mla_w_uq[l], mla_w_ukv[l], pos)
        y_b = swa_mixer(sq, sk, sv, swa_sinks[l], tab_swa)
        y_c = nsa_mixer(nq, nkc, nvc, nks, nvs, nkw, nvw, ngate,
                        nsa_cmp_pos[l], nsa_cmp_w1[l], nsa_cmp_w2[l], tab_nsa)
        y_d = diff_mixer(dq, dk, dv, diff_lambda[l], diff_subln[l], tab_diff, l)
        merged = jax.nn.sigmoid(u @ w_gate[l, 0]) * (y_a @ w_branch[l, 0])
        merged = merged + jax.nn.sigmoid(u @ w_gate[l, 1]) * (y_b @ w_branch[l, 1])
        merged = merged + jax.nn.sigmoid(u @ w_gate[l, 2]) * (y_c @ w_branch[l, 2])
        merged = merged + jax.nn.sigmoid(u @ w_gate[l, 3]) * (y_d @ w_branch[l, 3])
        h = h + merged @ w_o[l]
        h = h + 0.5 * swiglu(rmsnorm(h, norm_g[l, 2]), ffn_w_gate[l, 1], ffn_w_up[l, 1], ffn_w_down[l, 1])
    return rmsnorm(h, final_g)
```

```cpp
#include <hip/hip_runtime.h>
#include <hip/hip_cooperative_groups.h>
#include <cstdio>
#include <cstdint>
namespace cg = cooperative_groups;

#ifndef ONE_LAUNCH
#define ONE_LAUNCH 1
#endif

typedef unsigned short bf16_t;
typedef short bf16x8 __attribute__((ext_vector_type(8)));
typedef float f32x16 __attribute__((ext_vector_type(16)));
typedef float f32x4 __attribute__((ext_vector_type(4)));
typedef unsigned u32x4 __attribute__((ext_vector_type(4)));
typedef unsigned u32x2 __attribute__((ext_vector_type(2)));

#define DEVI __device__ __forceinline__
__device__ __forceinline__ int threadIdx_x_raw() { return (int)__builtin_amdgcn_workitem_id_x(); }

constexpr int MTOK = 32768, SEQ = 8192, DM = 1024, DFF = 2816;
constexpr float LOG2E = 1.4426950408889634f;
constexpr int SMEM_BYTES = 79872;
constexpr int NPHASE = 29;

constexpr size_t MiB = 1u << 20;
constexpr size_t OFF_W = 0;
constexpr size_t OFF_MISC = 24 * MiB;
constexpr size_t OFF_XN = 25 * MiB;
constexpr size_t OFF_BIG = 89 * MiB;
constexpr size_t OFF_SCR = 489 * MiB;
constexpr size_t WS_NEED = 505 * MiB;
constexpr size_t W_GU = 0, W_D = 11534336;
constexpr size_t W_IN = 0, W_G = 8 * MiB, W_B = 16 * MiB, W_O = 20 * MiB, W_UQ = 22 * MiB, W_UKV = 22 * MiB + 512 * 1024,
                 W_C1 = 22 * MiB + 768 * 1024, W_C2 = 23 * MiB + 768 * 1024;
constexpr size_t MISC_CTR = 0, MISC_BAR = 32768, MISC_LUT = 49152, MISC_CBIAS = 65536;
constexpr size_t MISC_ZERO_BYTES = 49152;
constexpr size_t B_ACT = 0;
constexpr size_t B_CQ = 0, B_CKV = 16 * MiB, B_KROPE = 24 * MiB, B_NGATE = 26 * MiB, B_SQ = 28 * MiB, B_SK = 60 * MiB, B_SVT = 68 * MiB,
                 B_NQ = 76 * MiB, B_NKC = 108 * MiB, B_NVC = 116 * MiB, B_NKS = 124 * MiB, B_NVST = 132 * MiB, B_NKW = 140 * MiB,
                 B_NVWT = 148 * MiB, B_DQ = 156 * MiB, B_DK = 188 * MiB, B_DVT = 220 * MiB, B_QN = 252 * MiB, B_QR = 284 * MiB,
                 B_KN = 300 * MiB, B_MVT = 332 * MiB, B_OC = 364 * MiB, B_HDN = 396 * MiB, B_KCMP = 398 * MiB,
                 B_VCMPT = 398 * MiB + 512 * 1024, B_SELM = 399 * MiB, B_MERGED = B_KN;

struct Params {
  const float *x, *norm_g, *w_in, *mla_q_norm, *mla_kv_norm, *mla_w_uq, *mla_w_ukv, *swa_sinks, *cmp_pos, *cmp_w1, *cmp_w2,
      *diff_lambda, *diff_subln, *rel_bias, *w_branch, *w_gate, *w_o, *ffn_w_gate, *ffn_w_up, *ffn_w_down, *final_g;
  float* out;
  char* ws;
};

struct Seg { int blk0, nblk, src_col, ld, mode; unsigned off_kib; };
__constant__ Seg c_segs[18] = {
  {0, 8, 0, 256, 0, (unsigned)(B_CQ >> 10)},      {8, 4, 256, 128, 0, (unsigned)(B_CKV >> 10)},   {12, 1, 384, 32, 2, (unsigned)(B_KROPE >> 10)},
  {13, 1, 2464, 32, 0, (unsigned)(B_NGATE >> 10)}, {14, 2, -1, 0, 3, 0},                           {16, 16, 416, 512, 0, (unsigned)(B_SQ >> 10)},
  {32, 4, 928, 128, 0, (unsigned)(B_SK >> 10)},   {36, 4, 1056, 128, 1, (unsigned)(B_SVT >> 10)}, {40, 16, 1184, 512, 0, (unsigned)(B_NQ >> 10)},
  {56, 4, 1696, 128, 0, (unsigned)(B_NKC >> 10)}, {60, 4, 1824, 128, 0, (unsigned)(B_NVC >> 10)}, {64, 4, 1952, 128, 0, (unsigned)(B_NKS >> 10)},
  {68, 4, 2080, 128, 1, (unsigned)(B_NVST >> 10)}, {72, 4, 2208, 128, 0, (unsigned)(B_NKW >> 10)}, {76, 4, 2336, 128, 1, (unsigned)(B_NVWT >> 10)},
  {80, 16, 2488, 512, 0, (unsigned)(B_DQ >> 10)}, {96, 16, 3000, 512, 0, (unsigned)(B_DK >> 10)}, {112, 16, 3512, 512, 1, (unsigned)(B_DVT >> 10)}};

DEVI int find_seg(int blk) {
  int s = 0;
#pragma unroll
  for (int i = 1; i < 18; ++i) if (blk >= c_segs[i].blk0) s = i;
  return s;
}

typedef float f32x2_t __attribute__((ext_vector_type(2)));
typedef __bf16 bf16x2_t __attribute__((ext_vector_type(2)));
DEVI unsigned pk2(float a, float b) { f32x2_t v = {a, b}; bf16x2_t r = __builtin_convertvector(v, bf16x2_t); return __builtin_bit_cast(unsigned, r); }
DEVI bf16_t f2bf(float a) { return (bf16_t)(pk2(a, 0.f) & 0xffffu); }
DEVI float bf2f(bf16_t v) { return __uint_as_float(((unsigned)v) << 16); }
DEVI float fexp2(float x) { return __builtin_amdgcn_exp2f(x); }
DEVI float frcp(float x) { return __builtin_amdgcn_rcpf(x); }
DEVI float sigm(float x) { return frcp(1.f + fexp2(-x * LOG2E)); }
DEVI f32x16 mfma32(bf16x8 a, bf16x8 b, f32x16 c) { return __builtin_amdgcn_mfma_f32_32x32x16_bf16(a, b, c, 0, 0, 0); }
DEVI float wave_sum(float v) {
#pragma unroll
  for (int o = 32; o >= 1; o >>= 1) v += __shfl_xor(v, o);
  return v;
}
DEVI int TID() { int t = threadIdx_x_raw(); asm volatile("" : "+v"(t)); return t; }
DEVI int rowoff(int reg, int h) { return (reg & 3) + 8 * (reg >> 2) + 4 * h; }
DEVI f32x16 zero16() { f32x16 z;
#pragma unroll
  for (int i = 0; i < 16; ++i) z[i] = 0.f; return z; }

DEVI int fetch_item(int* ctr, char* smem) {
  int* slot = (int*)(smem + SMEM_BYTES - 16);
  __syncthreads();
  if (TID() == 0) *slot = atomicAdd(ctr, 1);
  __syncthreads();
  return *slot;
}
DEVI int logical_block() { return (blockIdx.x & 7) * (gridDim.x >> 3) + (blockIdx.x >> 3); }

template <bool LOWREG = false>
DEVI void gemm_core(f32x16 (&acc)[2][2], const bf16_t* __restrict__ A, long lda, long a_kstep, const bf16_t* __restrict__ Bt, long ldb,
                    int nk, char* smem, bool swp = false) {
  const int tid = TID(), lane = tid & 63, w = tid >> 6, wm = w >> 1, wn = w & 1;
  bf16_t* sA = (bf16_t*)smem;
  bf16_t* sB = sA + 2 * 128 * 72;
  const int lr = tid >> 3, lc = (tid & 7) * 8;
  const bf16_t* ap = A + (long)lr * lda + lc;
  const bf16_t* bp = Bt + (long)lr * ldb + lc;
  const bf16_t* a_ = sA + (wm * 64 + (lane & 31)) * 72 + (lane >> 5) * 8;
  const bf16_t* b_ = sB + (wn * 64 + (lane & 31)) * 72 + (lane >> 5) * 8;
  auto gload = [&](u32x4 (&ra)[4], u32x4 (&rb)[4], int kt) {
#pragma unroll
    for (int i = 0; i < 4; ++i) {
      ra[i] = *(const u32x4*)(ap + (long)(32 * i) * lda + (long)kt * a_kstep);
      rb[i] = *(const u32x4*)(bp + (long)(32 * i) * ldb + (long)kt * 64);
    }
  };
  auto swrite = [&](const u32x4 (&ra)[4], const u32x4 (&rb)[4], int buf) {
#pragma unroll
    for (int i = 0; i < 4; ++i) { *(u32x4*)(sA + buf * 128 * 72 + (lr + 32 * i) * 72 + lc) = ra[i]; *(u32x4*)(sB + buf * 128 * 72 + (lr + 32 * i) * 72 + lc) = rb[i]; }
  };
  auto compute = [&](int buf) {
#pragma unroll
    for (int ks = 0; ks < 4; ++ks) {
      bf16x8 a0 = *(const bf16x8*)(a_ + buf * 128 * 72 + ks * 16), a1 = *(const bf16x8*)(a_ + buf * 128 * 72 + 32 * 72 + ks * 16);
      bf16x8 b0 = *(const bf16x8*)(b_ + buf * 128 * 72 + ks * 16), b1 = *(const bf16x8*)(b_ + buf * 128 * 72 + 32 * 72 + ks * 16);
      if (swp) {
        acc[0][0] = mfma32(b0, a0, acc[0][0]); acc[0][1] = mfma32(b1, a0, acc[0][1]);
        acc[1][0] = mfma32(b0, a1, acc[1][0]); acc[1][1] = mfma32(b1, a1, acc[1][1]);
      } else {
        acc[0][0] = mfma32(a0, b0, acc[0][0]); acc[0][1] = mfma32(a0, b1, acc[0][1]);
        acc[1][0] = mfma32(a1, b0, acc[1][0]); acc[1][1] = mfma32(a1, b1, acc[1][1]);
      }
    }
  };
  __syncthreads();
  if (LOWREG) {
    u32x4 ra[4], rb[4];
    gload(ra, rb, 0); swrite(ra, rb, 0);
    __syncthreads();
    for (int kt = 0; kt < nk; ++kt) {
      const int buf = kt & 1;
      if (kt + 1 < nk) gload(ra, rb, kt + 1);
      compute(buf);
      if (kt + 1 < nk) swrite(ra, rb, buf ^ 1);
      __syncthreads();
    }
  } else {
    u32x4 ra0[4], rb0[4], ra1[4], rb1[4];
    gload(ra0, rb0, 0); swrite(ra0, rb0, 0);
    if (nk > 1) gload(ra1, rb1, 1);
    __syncthreads();
    for (int kt = 0; kt < nk; kt += 2) {
      if (kt + 2 < nk) gload(ra0, rb0, kt + 2);
      compute(0);
      if (kt + 1 < nk) swrite(ra1, rb1, 1);
      __syncthreads();
      if (kt + 1 >= nk) break;
      if (kt + 3 < nk) gload(ra1, rb1, kt + 3);
      compute(1);
      if (kt + 2 < nk) swrite(ra0, rb0, 0);
      __syncthreads();
    }
  }
}
DEVI void zero_acc(f32x16 (&acc)[2][2]) { acc[0][0] = zero16(); acc[0][1] = zero16(); acc[1][0] = zero16(); acc[1][1] = zero16(); }
DEVI void tile_mn(int t, int NT, int& mt, int& nt, bool rev = false) { const int g = t / (2 * NT), r = t % (2 * NT); mt = 2 * g + (r & 1); nt = r >> 1; if (rev) mt = 127 - mt; }


struct GSeg { const bf16_t* A; long lda; long akstep; const bf16_t* Bt; long ldb; int nk; bool swp; };
template <bool ONESET = false, class SegFn, class EpiFn>
DEVI void gemm_stream(int nseg, SegFn segfn, EpiFn epi, char* smem) {
  if (nseg <= 0) return;
  const int tid = TID(), lane = tid & 63, w = tid >> 6, wm = w >> 1, wn = w & 1;
  bf16_t* sA = (bf16_t*)smem;
  bf16_t* sB = sA + 2 * 128 * 72;
  const int lr = tid >> 3, lc = (tid & 7) * 8;
  const bf16_t* a_ = sA + (wm * 64 + (lane & 31)) * 72 + (lane >> 5) * 8;
  const bf16_t* b_ = sB + (wn * 64 + (lane & 31)) * 72 + (lane >> 5) * 8;
  GSeg ls = segfn(0);
  int lj = 0, lk = 0;
  const bf16_t* ap = ls.A + (long)lr * ls.lda + lc;
  const bf16_t* bp = ls.Bt + (long)lr * ls.ldb + lc;
  auto advance_load = [&](u32x4 (&ra)[4], u32x4 (&rb)[4]) {
    if (lj >= nseg) return;
#pragma unroll
    for (int i = 0; i < 4; ++i) {
      ra[i] = *(const u32x4*)(ap + (long)(32 * i) * ls.lda + (long)lk * ls.akstep);
      rb[i] = *(const u32x4*)(bp + (long)(32 * i) * ls.ldb + (long)lk * 64);
    }
    if (++lk == ls.nk) { lk = 0; ++lj; if (lj < nseg) { ls = segfn(lj); ap = ls.A + (long)lr * ls.lda + lc; bp = ls.Bt + (long)lr * ls.ldb + lc; } }
  };
  auto swrite = [&](const u32x4 (&ra)[4], const u32x4 (&rb)[4], int buf) {
#pragma unroll
    for (int i = 0; i < 4; ++i) { *(u32x4*)(sA + buf * 128 * 72 + (lr + 32 * i) * 72 + lc) = ra[i]; *(u32x4*)(sB + buf * 128 * 72 + (lr + 32 * i) * 72 + lc) = rb[i]; }
  };
  f32x16 acc[2][2]; zero_acc(acc);
  bool cswp = ls.swp;
  auto compute = [&](int buf) {
#pragma unroll
    for (int ks = 0; ks < 4; ++ks) {
      bf16x8 a0 = *(const bf16x8*)(a_ + buf * 128 * 72 + ks * 16), a1 = *(const bf16x8*)(a_ + buf * 128 * 72 + 32 * 72 + ks * 16);
      bf16x8 b0 = *(const bf16x8*)(b_ + buf * 128 * 72 + ks * 16), b1 = *(const bf16x8*)(b_ + buf * 128 * 72 + 32 * 72 + ks * 16);
      if (cswp) {
        acc[0][0] = mfma32(b0, a0, acc[0][0]); acc[0][1] = mfma32(b1, a0, acc[0][1]);
        acc[1][0] = mfma32(b0, a1, acc[1][0]); acc[1][1] = mfma32(b1, a1, acc[1][1]);
      } else {
        acc[0][0] = mfma32(a0, b0, acc[0][0]); acc[0][1] = mfma32(a0, b1, acc[0][1]);
        acc[1][0] = mfma32(a1, b0, acc[1][0]); acc[1][1] = mfma32(a1, b1, acc[1][1]);
      }
    }
  };
  if (ONESET) {
    u32x4 ra[4], rb[4];
    __syncthreads();
    advance_load(ra, rb); swrite(ra, rb, 0); advance_load(ra, rb);
    __syncthreads();
    int cj = 0, ck = 0, cnk = segfn(0).nk, par = 0;
    while (cj < nseg) {
      compute(par);
      if (++ck == cnk) { epi(cj, acc); zero_acc(acc); ck = 0; ++cj; if (cj < nseg) { const GSeg ns = segfn(cj); cnk = ns.nk; cswp = ns.swp; } }
      if (cj < nseg) { swrite(ra, rb, par ^ 1); advance_load(ra, rb); }
      par ^= 1;
      __syncthreads();
    }
    return;
  }
  u32x4 ra0[4], rb0[4], ra1[4], rb1[4];
  advance_load(ra0, rb0); advance_load(ra1, rb1);
  __syncthreads();
  swrite(ra0, rb0, 0); advance_load(ra0, rb0);
  __syncthreads();
  int cj = 0, ck = 0, cnk = segfn(0).nk;
  while (cj < nseg) {
    compute(0);
    swrite(ra1, rb1, 1); advance_load(ra1, rb1);
    __syncthreads();
    compute(1);
    ck += 2;
    if (ck == cnk) { epi(cj, acc); zero_acc(acc); ck = 0; ++cj; if (cj < nseg) { const GSeg ns = segfn(cj); cnk = ns.nk; cswp = ns.swp; } }
    if (cj < nseg) { swrite(ra0, rb0, 0); advance_load(ra0, rb0); }
    __syncthreads();
  }
}


struct GSeg2 { const bf16_t* A; long lda; const bf16_t* Bt; long ldb; int nk2; bool swp; };
DEVI void zero_acc2(f32x16 (&acc)[4][2]) {
#pragma unroll
  for (int i = 0; i < 4; ++i) { acc[i][0] = zero16(); acc[i][1] = zero16(); }
}
template <class SegFn, class EpiFn>
DEVI void gemm_stream2(int nseg, SegFn segfn, EpiFn epi, char* smem) {
  if (nseg <= 0) return;
  const int tid = TID(), lane = tid & 63, w = tid >> 6, wm = w >> 1, wn = w & 1;
  bf16_t* sA = (bf16_t*)smem;
  bf16_t* sB = sA + 256 * 72;
  const int lr = tid >> 3, lc = (tid & 7) * 8;
  const bf16_t* a_ = sA + (wm * 128 + (lane & 31)) * 72 + (lane >> 5) * 8;
  const bf16_t* b_ = sB + (wn * 64 + (lane & 31)) * 72 + (lane >> 5) * 8;
  GSeg2 ls = segfn(0);
  int lj = 0, lk = 0;
  const bf16_t* ap = ls.A + (long)lr * ls.lda + lc;
  const bf16_t* bp = ls.Bt + (long)lr * ls.ldb + lc;
  u32x4 ra[8], rb[4];
  auto advance_load = [&]() {
    if (lj >= nseg) return;
#pragma unroll
    for (int i = 0; i < 8; ++i) ra[i] = *(const u32x4*)(ap + (long)(32 * i) * ls.lda + (long)lk * 64);
#pragma unroll
    for (int i = 0; i < 4; ++i) rb[i] = *(const u32x4*)(bp + (long)(32 * i) * ls.ldb + (long)lk * 64);
    if (++lk == ls.nk2) { lk = 0; ++lj; if (lj < nseg) { ls = segfn(lj); ap = ls.A + (long)lr * ls.lda + lc; bp = ls.Bt + (long)lr * ls.ldb + lc; } }
  };
  auto swrite = [&]() {
#pragma unroll
    for (int i = 0; i < 8; ++i) *(u32x4*)(sA + (lr + 32 * i) * 72 + lc) = ra[i];
#pragma unroll
    for (int i = 0; i < 4; ++i) *(u32x4*)(sB + (lr + 32 * i) * 72 + lc) = rb[i];
  };
  f32x16 acc[4][2]; zero_acc2(acc);
  bool cswp = ls.swp;
  auto compute = [&]() {
#pragma unroll
    for (int ks = 0; ks < 4; ++ks) {
      bf16x8 af[4], bfr[2];
#pragma unroll
      for (int mi = 0; mi < 4; ++mi) af[mi] = *(const bf16x8*)(a_ + mi * 32 * 72 + ks * 16);
#pragma unroll
      for (int ni = 0; ni < 2; ++ni) bfr[ni] = *(const bf16x8*)(b_ + ni * 32 * 72 + ks * 16);
      if (cswp) {
#pragma unroll
        for (int mi = 0; mi < 4; ++mi) { acc[mi][0] = mfma32(bfr[0], af[mi], acc[mi][0]); acc[mi][1] = mfma32(bfr[1], af[mi], acc[mi][1]); }
      } else {
#pragma unroll
        for (int mi = 0; mi < 4; ++mi) { acc[mi][0] = mfma32(af[mi], bfr[0], acc[mi][0]); acc[mi][1] = mfma32(af[mi], bfr[1], acc[mi][1]); }
      }
    }
  };
  advance_load();
  int cj = 0, ck = 0, cnk;
  { const GSeg2 s0 = segfn(0); cnk = s0.nk2; cswp = s0.swp; }
  while (cj < nseg) {
    __syncthreads();
    swrite();
    advance_load();
    __syncthreads();
    __builtin_amdgcn_s_setprio(2);
    compute();
    __builtin_amdgcn_s_setprio(0);
    if (++ck == cnk) { epi(cj, acc); zero_acc2(acc); ck = 0; ++cj; if (cj < nseg) { const GSeg2 ns = segfn(cj); cnk = ns.nk2; cswp = ns.swp; } }
  }
}

DEVI void st_rm(bf16_t* dst, long ld, long row0, const f32x16& a, int lane) {
  const int c = lane & 31, h = lane >> 5;
#pragma unroll
  for (int reg = 0; reg < 16; ++reg) dst[(row0 + rowoff(reg, h)) * ld + c] = f2bf(a[reg]);
}
DEVI void st_tr(bf16_t* dstT, long ldt, int s0, const f32x16& a, int lane) {
  const int c = lane & 31, h = lane >> 5;
#pragma unroll
  for (int t = 0; t < 4; ++t) {
    u32x2 v; v.x = pk2(a[4 * t], a[4 * t + 1]); v.y = pk2(a[4 * t + 2], a[4 * t + 3]);
    *(u32x2*)(dstT + (long)c * ldt + s0 + 8 * t + 4 * h) = v;
  }
}

DEVI void st_rm_s(bf16_t* dst, long ld, long tok0, const f32x16& a, int lane) {
  bf16_t* rp = dst + (tok0 + (lane & 31)) * ld + 4 * (lane >> 5);
#pragma unroll
  for (int t = 0; t < 4; ++t) { u32x2 v; v.x = pk2(a[4 * t], a[4 * t + 1]); v.y = pk2(a[4 * t + 2], a[4 * t + 3]); *(u32x2*)(rp + 8 * t) = v; }
}
DEVI void st_tr_s(bf16_t* dstT, long ldt, int s0, const f32x16& a, int lane) {
  bf16_t* cp = dstT + s0 + (lane & 31);
  const int h = lane >> 5;
#pragma unroll
  for (int reg = 0; reg < 16; ++reg) cp[(long)rowoff(reg, h) * ldt] = f2bf(a[reg]);
}
DEVI f32x16 rope_blk_s(const f32x16& a, int pos0, int lane) {
  const int h = lane >> 5; const float pos = (float)(pos0 + (lane & 31));
  f32x16 r;
#pragma unroll
  for (int reg = 0; reg < 8; ++reg) {
    const float fr = fexp2(-(float)rowoff(reg, h) * 0.8304820237218406f);
    const float ang = pos * fr;
    double rv = (double)ang * 0.15915494309189535; rv -= floor(rv);
    const float f = (float)rv, sn = __builtin_amdgcn_sinf(f), cs = __builtin_amdgcn_cosf(f);
    const float x1 = a[reg], x2 = a[reg + 8];
    r[reg] = x1 * cs - x2 * sn; r[reg + 8] = x1 * sn + x2 * cs;
  }
  return r;
}
DEVI f32x16 rope_blk(const f32x16& a, int s0, int lane) {
  const int c = lane & 31, h = lane >> 5;
  const float fr = fexp2(-(float)(c & 15) * 0.8304820237218406f);
  f32x16 r;
#pragma unroll
  for (int reg = 0; reg < 16; ++reg) {
    const float v = a[reg], pv = __shfl_xor(v, 16);
    const float ang = (float)(s0 + rowoff(reg, h)) * fr;
    double rv = (double)ang * 0.15915494309189535; rv -= floor(rv);
    const float f = (float)rv, sn = __builtin_amdgcn_sinf(f), cs = __builtin_amdgcn_cosf(f);
    r[reg] = (c < 16) ? (v * cs - pv * sn) : (pv * sn + v * cs);
  }
  return r;
}

DEVI void norm_rows(const float* __restrict__ src, const float* __restrict__ g, bf16_t* dst, float* dstf, int item) {
  const int lane = TID() & 63, w = TID() >> 6;
  const long row0 = (long)item * 16 + w * 4;
  f32x4 v[4][4];
#pragma unroll
  for (int r = 0; r < 4; ++r)
#pragma unroll
    for (int j = 0; j < 4; ++j) v[r][j] = *(const f32x4*)(src + (row0 + r) * DM + j * 256 + lane * 4);
  f32x4 gv[4];
#pragma unroll
  for (int j = 0; j < 4; ++j) gv[j] = *(const f32x4*)(g + j * 256 + lane * 4);
#pragma unroll
  for (int r = 0; r < 4; ++r) {
    float ss = 0.f;
#pragma unroll
    for (int j = 0; j < 4; ++j) ss += v[r][j][0] * v[r][j][0] + v[r][j][1] * v[r][j][1] + v[r][j][2] * v[r][j][2] + v[r][j][3] * v[r][j][3];
    ss = wave_sum(ss);
    const float rstd = rsqrtf(ss * (1.f / DM) + 1e-6f);
#pragma unroll
    for (int j = 0; j < 4; ++j) {
      const float o0 = v[r][j][0] * rstd * gv[j][0], o1 = v[r][j][1] * rstd * gv[j][1], o2 = v[r][j][2] * rstd * gv[j][2], o3 = v[r][j][3] * rstd * gv[j][3];
      if (dst) { u32x2 o; o.x = pk2(o0, o1); o.y = pk2(o2, o3); *(u32x2*)(dst + (row0 + r) * DM + j * 256 + lane * 4) = o; }
      else { f32x4 o = {o0, o1, o2, o3}; *(f32x4*)(dstf + (row0 + r) * DM + j * 256 + lane * 4) = o; }
    }
  }
}
DEVI void conv_tile(const float* __restrict__ src, long ld, int col0, int nvalid, const float* __restrict__ kscale, bf16_t* dst, long ldd,
                    int n0, int k0, char* smem) {
  float* t = (float*)smem;
  const int tid = TID();
  __syncthreads();
  {
    const int c = tid & 31, r0 = tid >> 5;
#pragma unroll
    for (int i = 0; i < 8; ++i) {
      const int k = r0 + 8 * i; float v = 0.f;
      if (c < nvalid) { v = src[(long)(k0 + k) * ld + col0 + c]; if (kscale) v *= kscale[k0 + k]; }
      t[k * 33 + c] = v;
    }
  }
  __syncthreads();
  {
    const int n = tid >> 3, kc = (tid & 7) * 8;
    u32x4 o;
    o.x = pk2(t[(kc + 0) * 33 + n], t[(kc + 1) * 33 + n]); o.y = pk2(t[(kc + 2) * 33 + n], t[(kc + 3) * 33 + n]);
    o.z = pk2(t[(kc + 4) * 33 + n], t[(kc + 5) * 33 + n]); o.w = pk2(t[(kc + 6) * 33 + n], t[(kc + 7) * 33 + n]);
    *(u32x4*)(dst + (long)(n0 + n) * ldd + k0 + kc) = o;
  }
}

DEVI void phase_norm_conv(const Params& p, int l, int which, char* smem, bool rev) {
  const float* hsrc = (l == 0 && which == 0) ? p.x : p.out;
  const float* g = p.norm_g + (l * 3 + which) * DM;
  bf16_t* xn = (bf16_t*)(p.ws + OFF_XN);
  char* W = p.ws + OFF_W;
  const int nnorm = MTOK / 16;
  int nconv;
  if (which != 1) nconv = 2816 + 1408; else nconv = 2048 + 2048 + 1024 + 512 + 96 + 64 + 256 + 16 + 64 + 1;
  const int total = nnorm + nconv;
  for (int it = logical_block(); it < total; it += gridDim.x) {
    if (it < nnorm) { norm_rows(hsrc, g, xn, nullptr, rev ? nnorm - 1 - it : it); continue; }
    int c = it - nnorm;
    if (which != 1) {
      const int fi = l * 2 + (which == 2 ? 1 : 0);
      if (c < 2816) {
        const int nb = c >> 4, kt = c & 15, j = nb >> 1, part = nb & 1;
        const float* src = (part ? p.ffn_w_up : p.ffn_w_gate) + (size_t)fi * DM * DFF;
        conv_tile(src, DFF, 32 * j, 32, nullptr, (bf16_t*)(W + W_GU), DM, nb * 32, kt * 64, smem);
      } else {
        c -= 2816; const int nb = c / 44, kt = c % 44;
        conv_tile(p.ffn_w_down + (size_t)fi * DFF * DM, DM, nb * 32, 32, nullptr, (bf16_t*)(W + W_D), DFF, nb * 32, kt * 64, smem);
      }
      continue;
    }
    if (c < 2048) { const int nb = c >> 4, kt = c & 15; const Seg& sg = c_segs[find_seg(nb)];
      const int nv = (sg.mode == 3) ? 0 : (nb == 13 ? 24 : 32);
      conv_tile(p.w_in + (size_t)l * DM * 4024, 4024, sg.src_col + 32 * (nb - sg.blk0), nv, nullptr, (bf16_t*)(W + W_IN), DM, nb * 32, kt * 64, smem); continue; }
    c -= 2048;
    if (c < 2048) { const int i = c >> 9, r = c & 511, nb = r >> 4, kt = r & 15;
      conv_tile(p.w_gate + ((size_t)l * 4 + i) * DM * DM, DM, nb * 32, 32, nullptr, (bf16_t*)(W + W_G) + (size_t)i * DM * DM, DM, nb * 32, kt * 64, smem); continue; }
    c -= 2048;
    if (c < 1024) { const int i = c >> 8, r = c & 255, nb = r >> 3, kt = r & 7;
      conv_tile(p.w_branch + ((size_t)l * 4 + i) * 512 * DM, DM, nb * 32, 32, nullptr, (bf16_t*)(W + W_B) + (size_t)i * DM * 512, 512, nb * 32, kt * 64, smem); continue; }
    c -= 1024;
    if (c < 512) { const int nb = c >> 4, kt = c & 15;
      conv_tile(p.w_o + (size_t)l * DM * DM, DM, nb * 32, 32, nullptr, (bf16_t*)(W + W_O), DM, nb * 32, kt * 64, smem); continue; }
    c -= 512;
    if (c < 96) { const int nb = c >> 2, kt = c & 3;
      conv_tile(p.mla_w_uq + (size_t)l * 256 * 768, 768, nb * 32, 32, p.mla_q_norm + l * 256, (bf16_t*)(W + W_UQ), 256, nb * 32, kt * 64, smem); continue; }
    c -= 96;
    if (c < 64) { const int nb = c >> 1, kt = c & 1;
      conv_tile(p.mla_w_ukv + (size_t)l * 128 * 1024, 1024, nb * 32, 32, p.mla_kv_norm + l * 128, (bf16_t*)(W + W_UKV), 128, nb * 32, kt * 64, smem); continue; }
    c -= 64;
    if (c < 256) { const int kv = c >> 7, r = c & 127, nb = r >> 5, kt = r & 31;
      conv_tile(p.cmp_w1 + ((size_t)l * 2 + kv) * 2048 * 128, 128, nb * 32, 32, nullptr, (bf16_t*)(W + W_C1) + (size_t)kv * 128 * 2048, 2048, nb * 32, kt * 64, smem); continue; }
    c -= 256;
    if (c < 16) { const int kv = c >> 3, r = c & 7, nb = r >> 1, kt = r & 1;
      conv_tile(p.cmp_w2 + ((size_t)l * 2 + kv) * 128 * 64, 64, (nb & 1) * 32, nb < 2 ? 32 : 0, nullptr, (bf16_t*)(W + W_C2) + (size_t)kv * 128 * 128, 128, nb * 32, kt * 64, smem); continue; }
    c -= 16;
    if (c < 64) {
      const int kv = c >> 5, ch = c & 31, tid = TID(), j = tid & 127, hf = tid >> 7;
      const float* pos = p.cmp_pos + ((size_t)l * 2 + kv) * 2048; const float* w1 = p.cmp_w1 + ((size_t)l * 2 + kv) * 2048 * 128;
      float s = 0.f;
      const int k0 = ch * 64 + hf * 32;
#pragma unroll 8
      for (int k = k0; k < k0 + 32; ++k) s += pos[k] * w1[(size_t)k * 128 + j];
      float* t = (float*)smem;
      __syncthreads(); if (hf) t[j] = s; __syncthreads();
      if (!hf) ((float*)(p.ws + OFF_MISC + MISC_CBIAS))[(kv * 32 + ch) * 128 + j] = s + t[j];
      continue;
    }
    c -= 64;
    {
      float* lut = (float*)(p.ws + OFF_MISC + MISC_LUT);
      for (int idx = TID(); idx < 20 * 129; idx += 256) {
        const int hd = idx / 129, d = idx % 129; int bk;
        if (d < 16) bk = d; else { bk = 16 + (int)(logf((float)d / 16.f) / logf(8.f) * 16.f); if (bk > 31) bk = 31; }
        lut[hd * 132 + d] = p.rel_bias[bk * 20 + hd] * LOG2E;
      }
    }
  }
}

DEVI void phase_ffn_up(const Params& p, char* smem, bool rev) {
  const bf16_t* xn = (const bf16_t*)(p.ws + OFF_XN);
  const bf16_t* wgu = (const bf16_t*)(p.ws + OFF_W + W_GU);
  bf16_t* act = (bf16_t*)(p.ws + OFF_BIG + B_ACT);
  const int NT = 44, ntiles = 128 * NT, lb = logical_block(), G = gridDim.x;
  const int nseg = lb < ntiles ? (ntiles - lb + G - 1) / G : 0;
  auto segfn = [&](int j) { int mt, nt; tile_mn(lb + j * G, NT, mt, nt, rev); GSeg2 g; g.A = xn + (size_t)mt * 256 * DM; g.lda = DM; g.Bt = wgu + (size_t)nt * 128 * DM; g.ldb = DM; g.nk2 = 16; g.swp = true; return g; };
  auto epi = [&](int j, f32x16 (&acc)[4][2]) {
    int mt, nt; tile_mn(lb + j * G, NT, mt, nt, rev);
    const int t2 = TID(), lane = t2 & 63, w = t2 >> 6, wm = w >> 1, wn = w & 1;
    const int f0 = (nt * 128 + wn * 64) / 2 + 4 * (lane >> 5);
#pragma unroll
    for (int mi = 0; mi < 4; ++mi) {
      bf16_t* rp = act + ((long)mt * 256 + wm * 128 + mi * 32 + (lane & 31)) * DFF + f0;
#pragma unroll
      for (int t = 0; t < 4; ++t) {
        float o[4];
#pragma unroll
        for (int e = 0; e < 4; ++e) { const float g = acc[mi][0][4 * t + e], u = acc[mi][1][4 * t + e]; o[e] = g * sigm(g) * u; }
        u32x2 v; v.x = pk2(o[0], o[1]); v.y = pk2(o[2], o[3]); *(u32x2*)(rp + 8 * t) = v;
      }
    }
  };
  gemm_stream2(nseg, segfn, epi, smem);
}
DEVI void gemm_resid_phase(const bf16_t* A, int lda, int nk, const bf16_t* Bt, const float* res, float* out, float alpha, char* smem, bool rev) {
  const int NT = 8, ntiles = 128 * NT, lb = logical_block(), G = gridDim.x;
  const int nseg = lb < ntiles ? (ntiles - lb + G - 1) / G : 0;
  auto segfn = [&](int j) { int mt, nt; tile_mn(lb + j * G, NT, mt, nt, rev); GSeg2 g; g.A = A + (size_t)mt * 256 * lda; g.lda = lda; g.Bt = Bt + (size_t)nt * 128 * lda; g.ldb = lda; g.nk2 = nk; g.swp = true; return g; };
  auto epi = [&](int j, f32x16 (&acc)[4][2]) {
    int mt, nt; tile_mn(lb + j * G, NT, mt, nt, rev);
    const int t2 = TID(), lane = t2 & 63, w = t2 >> 6, wm = w >> 1, wn = w & 1;
#pragma unroll
    for (int mi = 0; mi < 4; ++mi)
#pragma unroll
      for (int ni = 0; ni < 2; ++ni) {
        const long idx0 = ((long)mt * 256 + wm * 128 + mi * 32 + (lane & 31)) * DM + nt * 128 + wn * 64 + ni * 32 + 4 * (lane >> 5);
#pragma unroll
        for (int t = 0; t < 4; ++t) {
          const f32x4 r = *(const f32x4*)(res + idx0 + 8 * t);
          f32x4 o = {r[0] + alpha * acc[mi][ni][4 * t], r[1] + alpha * acc[mi][ni][4 * t + 1], r[2] + alpha * acc[mi][ni][4 * t + 2], r[3] + alpha * acc[mi][ni][4 * t + 3]};
          *(f32x4*)(out + idx0 + 8 * t) = o;
        }
      }
  };
  gemm_stream2(nseg, segfn, epi, smem);
}

DEVI void phase_win(const Params& p, char* smem, bool rev) {
  const bf16_t* u = (const bf16_t*)(p.ws + OFF_XN);
  const bf16_t* win = (const bf16_t*)(p.ws + OFF_W + W_IN);
  char* big = p.ws + OFF_BIG;
  const int NT = 32, ntiles = 128 * NT, lb = logical_block(), G = gridDim.x;
  const int nseg = lb < ntiles ? (ntiles - lb + G - 1) / G : 0;
  auto segfn = [&](int j) { int mt, nt; tile_mn(lb + j * G, NT, mt, nt, rev); GSeg2 g; g.A = u + (size_t)mt * 256 * DM; g.lda = DM; g.Bt = win + (size_t)nt * 128 * DM; g.ldb = DM; g.nk2 = 16; g.swp = true; return g; };
  auto epi = [&](int j, f32x16 (&acc)[4][2]) {
    int mt, nt; tile_mn(lb + j * G, NT, mt, nt, rev);
    const int t2 = TID(), lane = t2 & 63, w = t2 >> 6, wm = w >> 1, wn = w & 1;
    const long tok0 = (long)mt * 256 + wm * 128;
#pragma unroll
    for (int ni = 0; ni < 2; ++ni) {
      const int blk = nt * 4 + wn * 2 + ni;
      const Seg sg = c_segs[find_seg(blk)];
      bf16_t* base = (bf16_t*)(big + ((size_t)sg.off_kib << 10));
      const int cb = 32 * (blk - sg.blk0);
      if (sg.mode == 0) {
#pragma unroll
        for (int mi = 0; mi < 4; ++mi) st_rm_s(base + cb, sg.ld, tok0 + mi * 32, acc[mi][ni], lane);
      } else if (sg.mode == 1) {
        const int b = (int)(tok0 >> 13), sq = (int)(tok0 & (SEQ - 1));
#pragma unroll
        for (int mi = 0; mi < 4; ++mi) st_tr_s(base + ((size_t)b * sg.ld + cb) * SEQ, SEQ, sq + mi * 32, acc[mi][ni], lane);
      } else if (sg.mode == 2) {
#pragma unroll
        for (int mi = 0; mi < 4; ++mi) { f32x16 r = rope_blk_s(acc[mi][ni], (int)((tok0 + mi * 32) & (SEQ - 1)), lane); st_rm_s(base + cb, sg.ld, tok0 + mi * 32, r, lane); }
      }
    }
  };
  gemm_stream2(nseg, segfn, epi, smem);
}

template <int DK, int DV, int MODE>
DEVI void flash_loop(f32x16 (&o)[DV / 32], float& m_, float& l_, const bf16x8 (&qf)[DK / 16], const bf16_t* __restrict__ kA, long ldkA,
                     const bf16_t* __restrict__ kB, long ldkB, const bf16_t* __restrict__ vt, long ldv, int kt0, int kt1, int q, int qa,
                     int W, const float* lut, float bias_far, float sc, u32x4 selm, char* smem) {
  constexpr int KS = DK + 8, VS = 68, KCH = DK / 8, NKC = KCH * 64 / 256, NVC = DV * 8 / 256;
  const int tid = TID(), lane = tid & 63, h = lane >> 5;
  bf16_t* sK = (bf16_t*)smem;
  bf16_t* sV = sK + 2 * 64 * KS;
  u32x4 rk[NKC], rv[NVC];
  auto gload = [&](int kt) {
#pragma unroll
    for (int i = 0; i < NKC; ++i) {
      const int c = tid + 256 * i, r = c / KCH, kc = c % KCH; const long key = (long)kt * 64 + r;
      if (DK == 64 || kc < 8) rk[i] = *(const u32x4*)(kA + key * ldkA + kc * 8);
      else rk[i] = *(const u32x4*)(kB + key * ldkB + (kc - 8) * 8);
    }
#pragma unroll
    for (int i = 0; i < NVC; ++i) { const int c = tid + 256 * i, r = c >> 3, kc = c & 7; rv[i] = *(const u32x4*)(vt + (long)r * ldv + (long)kt * 64 + kc * 8); }
  };
  auto swrite = [&](int buf) {
#pragma unroll
    for (int i = 0; i < NKC; ++i) { const int c = tid + 256 * i, r = c / KCH, kc = c % KCH; *(u32x4*)(sK + buf * 64 * KS + r * KS + kc * 8) = rk[i]; }
#pragma unroll
    for (int i = 0; i < NVC; ++i) {
      const int c = tid + 256 * i, r = c >> 3, kc = c & 7; bf16_t* d = sV + buf * DV * VS + r * VS + kc * 8;
      u32x2 lo = {rv[i][0], rv[i][1]}, hi = {rv[i][2], rv[i][3]}; *(u32x2*)d = lo; *(u32x2*)(d + 4) = hi;
    }
  };
  __syncthreads();
  if (kt0 < kt1) { gload(kt0); swrite(0); }
  __syncthreads();
  for (int kt = kt0; kt < kt1; ++kt) {
    const int buf = (kt - kt0) & 1;
    if (kt + 1 < kt1) gload(kt + 1);
    const int kb = kt * 64;
    bool skip, fast; bool lane_ok = true;
    if (MODE == 0) { skip = kb > qa + 31; fast = kb + 63 <= qa; }
    else if (MODE == 1) { skip = (kb > qa + 31) || (kb + 63 < qa - (W - 1)); fast = (kb + 63 <= qa) && (qa + 31 - kb < W) && (qa - (kb + 63) >= 128); }
    else if (MODE == 2) { skip = 16 * kb > qa; fast = 16 * (kb + 63) + 31 <= qa; }
    else {
      const unsigned wsel = (kt < 32) ? selm[0] : (kt < 64) ? selm[1] : (kt < 96) ? selm[2] : selm[3];
      lane_ok = (wsel >> (kt & 31)) & 1u;
      skip = (kb > qa + 31) || (__ballot(lane_ok) == 0ull); fast = (qa - (kb + 63) >= 128);
    }
    if (!skip) {
      f32x16 s[2]; s[0] = zero16(); s[1] = zero16();
      const bf16_t* kp = sK + buf * 64 * KS + (lane & 31) * KS + h * 8;
      if (MODE == 2) {
#pragma unroll
        for (int ks = 0; ks < DK / 16; ++ks) {
          const bf16x8 a0 = *(const bf16x8*)(kp + ks * 16), a1 = *(const bf16x8*)(kp + 32 * KS + ks * 16);
          s[0] = mfma32(a0, qf[ks], s[0]); s[1] = mfma32(a1, qf[ks], s[1]);
        }
      } else {
        constexpr int KG = DK / 16;
#pragma unroll
        for (int g0 = 0; g0 < DK / 16; g0 += KG) {
          bf16x8 kf0[KG], kf1[KG];
#pragma unroll
          for (int ks = 0; ks < KG; ++ks) { kf0[ks] = *(const bf16x8*)(kp + (g0 + ks) * 16); kf1[ks] = *(const bf16x8*)(kp + 32 * KS + (g0 + ks) * 16); }
          __builtin_amdgcn_sched_barrier(0);
#pragma unroll
          for (int ks = 0; ks < KG; ++ks) { s[0] = mfma32(kf0[ks], qf[g0 + ks], s[0]); s[1] = mfma32(kf1[ks], qf[g0 + ks], s[1]); }
        }
      }
      constexpr int VPRE = (MODE == 2) ? 0 : (MODE == 0) ? 2 : 1;
      const bf16_t* vp = sV + buf * DV * VS + (lane & 31) * VS + h * 4;
      u32x4 vf[VPRE + 1][4];
#pragma unroll
      for (int dvb = 0; dvb < VPRE; ++dvb)
#pragma unroll
        for (int kk = 0; kk < 4; ++kk) {
          const u32x2 lo = *(const u32x2*)(vp + dvb * 32 * VS + kk * 16), hi = *(const u32x2*)(vp + dvb * 32 * VS + kk * 16 + 8);
          vf[dvb][kk] = (u32x4){lo.x, lo.y, hi.x, hi.y};
        }
      __builtin_amdgcn_sched_barrier(0);
      float mx = -__builtin_huge_valf();
      const float cb = (MODE == 1 || MODE == 3) ? bias_far : 0.f;
      if (fast) {
#pragma unroll
        for (int b2 = 0; b2 < 2; ++b2)
#pragma unroll
          for (int reg = 0; reg < 16; ++reg) mx = fmaxf(mx, s[b2][reg]);
        mx = __builtin_fmaf(mx, sc, cb);
        if (MODE == 3) mx = lane_ok ? mx : -__builtin_huge_valf();
      } else {
#pragma unroll
        for (int b2 = 0; b2 < 2; ++b2)
#pragma unroll
          for (int reg = 0; reg < 16; ++reg) {
            const int key = kb + b2 * 32 + rowoff(reg, h);
            bool ok; float t;
            if (MODE == 2) { ok = 16 * key + 31 <= q; t = s[b2][reg] * sc; }
            else {
              const int d = q - key; ok = d >= 0;
              if (MODE == 1) ok = ok && (d < W);
              if (MODE == 3) ok = ok && lane_ok;
              float bias = 0.f;
              if (MODE == 1 || MODE == 3) { int di = d < 0 ? 0 : (d > 128 ? 128 : d); bias = lut[di]; }
              t = __builtin_fmaf(s[b2][reg], sc, bias);
            }
            t = ok ? t : -__builtin_huge_valf();
            s[b2][reg] = t; mx = fmaxf(mx, t);
          }
      }
      mx = fmaxf(mx, __shfl_xor(mx, 32));
      if (__ballot(mx - m_ > 8.f) != 0ull) {
        const float mnew = fmaxf(m_, mx);
        const float mu = (mnew == -__builtin_huge_valf()) ? 0.f : mnew;
        const float alpha = fexp2(m_ - mu);
        m_ = mnew; l_ *= alpha;
#pragma unroll
        for (int dvb = 0; dvb < DV / 32; ++dvb)
#pragma unroll
          for (int reg = 0; reg < 16; ++reg) o[dvb][reg] *= alpha;
      }
      const float muse = (m_ == -__builtin_huge_valf()) ? 0.f : m_;
      float ls = 0.f;
      if (fast) {
        const float off = cb - muse;
#pragma unroll
        for (int b2 = 0; b2 < 2; ++b2)
#pragma unroll
          for (int reg = 0; reg < 16; ++reg) {
            float pz = fexp2(__builtin_fmaf(s[b2][reg], sc, off));
            if (MODE == 3) pz = lane_ok ? pz : 0.f;
            s[b2][reg] = pz; ls += pz;
          }
      } else {
#pragma unroll
        for (int b2 = 0; b2 < 2; ++b2)
#pragma unroll
          for (int reg = 0; reg < 16; ++reg) { const float pz = fexp2(s[b2][reg] - muse); s[b2][reg] = pz; ls += pz; }
      }
      l_ += ls;
      bf16x8 pb[4];
#pragma unroll
      for (int kk = 0; kk < 4; ++kk) {
        const int b2 = kk >> 1, s8 = (kk & 1) * 8;
        u32x4 pv; pv.x = pk2(s[b2][s8 + 0], s[b2][s8 + 1]); pv.y = pk2(s[b2][s8 + 2], s[b2][s8 + 3]);
        pv.z = pk2(s[b2][s8 + 4], s[b2][s8 + 5]); pv.w = pk2(s[b2][s8 + 6], s[b2][s8 + 7]);
        pb[kk] = __builtin_bit_cast(bf16x8, pv);
      }
#pragma unroll
      for (int dvb = 0; dvb < VPRE; ++dvb)
#pragma unroll
        for (int kk = 0; kk < 4; ++kk) o[dvb] = mfma32(__builtin_bit_cast(bf16x8, vf[dvb][kk]), pb[kk], o[dvb]);
#pragma unroll
      for (int dvb = VPRE; dvb < DV / 32; ++dvb) {
        u32x4 vv[4];
#pragma unroll
        for (int kk = 0; kk < 4; ++kk) {
          const u32x2 lo = *(const u32x2*)(vp + dvb * 32 * VS + kk * 16), hi = *(const u32x2*)(vp + dvb * 32 * VS + kk * 16 + 8);
          vv[kk] = (u32x4){lo.x, lo.y, hi.x, hi.y};
        }
        __builtin_amdgcn_sched_barrier(0);
#pragma unroll
        for (int kk = 0; kk < 4; ++kk) o[dvb] = mfma32(__builtin_bit_cast(bf16x8, vv[kk]), pb[kk], o[dvb]);
      }
      if (kt + 1 < kt1) swrite(buf ^ 1);
    } else if (kt + 1 < kt1) swrite(buf ^ 1);
    __syncthreads();
  }
}

template <int NK>
DEVI void load_qf(bf16x8 (&qf)[NK], const bf16_t* qrow, int h, int ks0) {
#pragma unroll
  for (int ks = 0; ks < NK; ++ks) if (ks >= ks0) qf[ks] = *(const bf16x8*)(qrow + (ks - ks0) * 16 + 8 * h);
}
template <int NB>
DEVI void store_o(const f32x16 (&o)[NB], float scale, bf16_t* dst, int h) {
#pragma unroll
  for (int dvb = 0; dvb < NB; ++dvb)
#pragma unroll
    for (int t = 0; t < 4; ++t) {
      u32x2 v; v.x = pk2(o[dvb][4 * t] * scale, o[dvb][4 * t + 1] * scale); v.y = pk2(o[dvb][4 * t + 2] * scale, o[dvb][4 * t + 3] * scale);
      *(u32x2*)(dst + dvb * 32 + 8 * t + 4 * h) = v;
    }
}
DEVI void load_lut(const Params& p, int hd, char* smem, float*& lut, float& far_) {
  lut = (float*)(smem + 60000);
  const float* g = (const float*)(p.ws + OFF_MISC + MISC_LUT) + hd * 132;
  __syncthreads();
  if (TID() < 129) lut[TID()] = g[TID()];
  __syncthreads();
  far_ = g[128];
}

DEVI void item_swa(const Params& p, int l, int b, int head, int qb, char* smem) {
  const int hkv = head >> 2;
  const int lane = TID() & 63, w = TID() >> 6, h = lane >> 5;
  char* big = p.ws + OFF_BIG;
  const int q0 = qb * 128, qa = q0 + 32 * w, q = qa + (lane & 31);
  float* lut; float far_; load_lut(p, head, smem, lut, far_);
  bf16_t* qrow = (bf16_t*)(big + B_SQ) + ((size_t)b * SEQ + q) * 512 + head * 64;
  bf16x8 qf[4]; load_qf<4>(qf, qrow, h, 0);
  f32x16 o[2]; o[0] = zero16(); o[1] = zero16();
  float m_ = p.swa_sinks[l * 8 + head] * LOG2E, l_ = h ? 0.f : 1.f;
  const bf16_t* kA = (const bf16_t*)(big + B_SK) + (size_t)b * SEQ * 128 + hkv * 64;
  const bf16_t* vt = (const bf16_t*)(big + B_SVT) + ((size_t)b * 128 + hkv * 64) * SEQ;
  int kt0 = q0 / 64 - 2; if (kt0 < 0) kt0 = 0;
  u32x4 sm = {0, 0, 0, 0};
  flash_loop<64, 64, 1>(o, m_, l_, qf, kA, 128, nullptr, 0, vt, SEQ, kt0, q0 / 64 + 2, q, qa, 128, lut, far_, 0.125f * LOG2E, sm, smem);
  const float lt = l_ + __shfl_xor(l_, 32);
  store_o<2>(o, frcp(lt), qrow, h);
}

DEVI void item_mla(const Params& p, int b, int head, int qb, char* smem) {
  const int lane = TID() & 63, w = TID() >> 6, h = lane >> 5;
  char* big = p.ws + OFF_BIG;
  const int q0 = qb * 128, qa = q0 + 32 * w, q = qa + (lane & 31);
  bf16_t* qrow = (bf16_t*)(big + B_QN) + ((size_t)b * SEQ + q) * 512 + head * 64;
  const bf16_t* qrr = (const bf16_t*)(big + B_QR) + ((size_t)b * SEQ + q) * 256 + head * 32;
  bf16x8 qf[6];
#pragma unroll
  for (int ks = 0; ks < 4; ++ks) qf[ks] = *(const bf16x8*)(qrow + ks * 16 + 8 * h);
#pragma unroll
  for (int ks = 0; ks < 2; ++ks) qf[4 + ks] = *(const bf16x8*)(qrr + ks * 16 + 8 * h);
  f32x16 o[2]; o[0] = zero16(); o[1] = zero16();
  float m_ = -__builtin_huge_valf(), l_ = 0.f;
  const bf16_t* kA = (const bf16_t*)(big + B_KN) + (size_t)b * SEQ * 512 + head * 64;
  const bf16_t* kB = (const bf16_t*)(big + B_KROPE) + (size_t)b * SEQ * 32;
  const bf16_t* vt = (const bf16_t*)(big + B_MVT) + ((size_t)b * 512 + head * 64) * SEQ;
  u32x4 sm = {0, 0, 0, 0};
  flash_loop<96, 64, 0>(o, m_, l_, qf, kA, 512, kB, 32, vt, SEQ, 0, q0 / 64 + 2, q, qa, 0, nullptr, 0.f, 0.10206207261596575f * LOG2E, sm, smem);
  const float lt = l_ + __shfl_xor(l_, 32);
  store_o<2>(o, frcp(lt), qrow, h);
}

DEVI void item_diff(const Params& p, int l, int b, int hd, int qb, char* smem) {
  char* big = p.ws + OFF_BIG;
  const int q0 = qb * 128;
  float* lut; float far_; load_lut(p, 16 + hd, smem, lut, far_);
  const bf16_t* kA = (const bf16_t*)(big + B_DK) + (size_t)b * SEQ * 512 + hd * 128;
  const bf16_t* vt = (const bf16_t*)(big + B_DVT) + ((size_t)b * 512 + hd * 128) * SEQ;
  const u32x4 sm = {0, 0, 0, 0};
  f32x16 o[4];
#pragma unroll 1
  for (int pass = 0; pass < 2; ++pass) {
#pragma unroll
    for (int i = 0; i < 4; ++i) o[i] = zero16();
    float m_ = -__builtin_huge_valf(), l_ = 0.f;
    {
      const int t = TID(), lane = t & 63, w = t >> 6, h = lane >> 5, qa = q0 + 32 * w, q = qa + (lane & 31);
      const bf16_t* qrow = (const bf16_t*)(big + B_DQ) + ((size_t)b * SEQ + q) * 512 + hd * 128 + pass * 64;
      bf16x8 qf[4]; load_qf<4>(qf, qrow, h, 0);
      flash_loop<64, 128, 1>(o, m_, l_, qf, kA + pass * 64, 512, nullptr, 0, vt, SEQ, 0, q0 / 64 + 2, q, qa, 1 << 30, lut, far_, 0.125f * LOG2E, sm, smem);
    }
    if (pass == 0) {
      const float il = frcp(l_ + __shfl_xor(l_, 32));
      unsigned* scr = (unsigned*)(p.ws + OFF_SCR) + (size_t)blockIdx.x * 8192 + TID();
#pragma unroll
      for (int i = 0; i < 4; ++i)
#pragma unroll
        for (int r = 0; r < 8; ++r) scr[(i * 8 + r) * 256] = pk2(o[i][2 * r] * il, o[i][2 * r + 1] * il);
    } else {
      const int t = TID(), lane = t & 63, w = t >> 6, h = lane >> 5, q = q0 + 32 * w + (lane & 31);
      const float lam_init = 0.8f - 0.6f * __expf(-0.3f * (float)l);
      float lam;
      { const float* lp = p.diff_lambda + l * 256; float a = wave_sum(lp[lane] * lp[64 + lane]), c = wave_sum(lp[128 + lane] * lp[192 + lane]); lam = __expf(a) - __expf(c) + lam_init; }
      const float il = frcp(l_ + __shfl_xor(l_, 32)) * lam;
      const unsigned* scr = (const unsigned*)(p.ws + OFF_SCR) + (size_t)blockIdx.x * 8192 + t;
      float ss = 0.f;
#pragma unroll
      for (int i = 0; i < 4; ++i)
#pragma unroll
        for (int r = 0; r < 8; ++r) {
          const unsigned sv = scr[(i * 8 + r) * 256];
          const float a0 = __uint_as_float(sv << 16), a1 = __uint_as_float(sv & 0xffff0000u);
          const float v0 = a0 - o[i][2 * r] * il, v1 = a1 - o[i][2 * r + 1] * il;
          o[i][2 * r] = v0; o[i][2 * r + 1] = v1; ss += v0 * v0 + v1 * v1;
        }
      ss += __shfl_xor(ss, 32);
      const float rstd = rsqrtf(ss * (1.f / 128.f) + 1e-6f) * (1.f - lam_init);
      const float* sub = p.diff_subln + l * 128;
      bf16_t* qrow = (bf16_t*)(big + B_DQ) + ((size_t)b * SEQ + q) * 512 + hd * 128;
#pragma unroll
      for (int i = 0; i < 4; ++i)
#pragma unroll
        for (int tq = 0; tq < 4; ++tq) {
          const int dv = i * 32 + 8 * tq + 4 * h;
          const f32x4 gv = *(const f32x4*)(sub + dv);
          u32x2 v; v.x = pk2(o[i][4 * tq] * rstd * gv[0], o[i][4 * tq + 1] * rstd * gv[1]); v.y = pk2(o[i][4 * tq + 2] * rstd * gv[2], o[i][4 * tq + 3] * rstd * gv[3]);
          *(u32x2*)(qrow + dv) = v;
        }
    }
  }
}

DEVI void item_cmp(const Params& p, int bh, int qb, char* smem) {
  const int b = bh >> 1, hkv = bh & 1;
  const int tid = TID(), lane = tid & 63, w = tid >> 6, h = lane >> 5, c = lane & 31;
  char* big = p.ws + OFF_BIG;
  const int q0 = qb * 128, qa = q0 + 32 * w, q = qa + c;
  const bf16_t* kA = (const bf16_t*)(big + B_KCMP) + (size_t)bh * 512 * 64;
  const bf16_t* vt = (const bf16_t*)(big + B_VCMPT) + (size_t)bh * 64 * 512;
  int ntiles = ((q0 + 127 - 31) >> 4) / 64 + 1; if (ntiles > 8) ntiles = 8;
  const float sc = 0.125f * LOG2E;
  const size_t tok = (size_t)b * SEQ + q;
  const bf16_t* qbase = (const bf16_t*)(big + B_NQ) + tok * 512 + hkv * 256;
  const bf16_t* gate = (const bf16_t*)(big + B_NGATE) + tok * 32 + hkv * 12;
  float mg[4], ilg[4];
  u32x4 sm = {0, 0, 0, 0};
#pragma unroll
  for (int g = 0; g < 4; ++g) {
    bf16x8 qf[4]; load_qf<4>(qf, qbase + g * 64, h, 0);
    f32x16 o[2]; o[0] = zero16(); o[1] = zero16();
    float m_ = -__builtin_huge_valf(), l_ = 0.f;
    flash_loop<64, 64, 2>(o, m_, l_, qf, kA, 64, nullptr, 0, vt, 512, 0, ntiles, q, qa, 0, nullptr, 0.f, sc, sm, smem);
    const float lt = l_ + __shfl_xor(l_, 32);
    const float il = lt > 0.f ? frcp(lt) : 0.f;
    mg[g] = m_; ilg[g] = il;
    const float g0 = sigm(bf2f(gate[g * 3 + 0]));
    store_o<2>(o, il * g0, (bf16_t*)(big + B_OC) + tok * 512 + (hkv * 4 + g) * 64, h);
  }
  bf16_t* sK = (bf16_t*)smem;
  float* imp = (float*)(smem + 9216);
  float carry = 0.f;
  const int cur = q >> 6;
  for (int kt = 0; kt < 8; ++kt) {
    __syncthreads();
    if (kt < ntiles) {
#pragma unroll
      for (int i = 0; i < 2; ++i) { const int ch = tid + 256 * i, r = ch >> 3, kc = ch & 7; *(u32x4*)(sK + r * 72 + kc * 8) = *(const u32x4*)(kA + ((size_t)kt * 64 + r) * 64 + kc * 8); }
    }
    __syncthreads();
    f32x16 ps[2]; ps[0] = zero16(); ps[1] = zero16();
    const int kb = kt * 64;
    if (kt < ntiles && 16 * kb <= qa) {
      const bf16_t* kp = sK + c * 72 + h * 8;
#pragma unroll
      for (int g = 0; g < 4; ++g) {
        f32x16 s[2]; s[0] = zero16(); s[1] = zero16();
        bf16x8 qf[4]; load_qf<4>(qf, qbase + g * 64, h, 0);
#pragma unroll
        for (int ks = 0; ks < 4; ++ks) {
          const bf16x8 a0 = *(const bf16x8*)(kp + ks * 16), a1 = *(const bf16x8*)(kp + 32 * 72 + ks * 16);
          s[0] = mfma32(a0, qf[ks], s[0]); s[1] = mfma32(a1, qf[ks], s[1]);
        }
#pragma unroll
        for (int b2 = 0; b2 < 2; ++b2)
#pragma unroll
          for (int reg = 0; reg < 16; ++reg) {
            const int key = kb + b2 * 32 + rowoff(reg, h);
            const bool ok = 16 * key + 31 <= q;
            const float pz = fexp2(s[b2][reg] * sc - mg[g]) * ilg[g];
            ps[b2][reg] += ok ? pz : 0.f;
          }
      }
    }
    float ol[2][4];
#pragma unroll
    for (int b2 = 0; b2 < 2; ++b2)
#pragma unroll
      for (int t = 0; t < 4; ++t) ol[b2][t] = __shfl_xor(ps[b2][4 * t + 3], 32);
#pragma unroll
    for (int b2 = 0; b2 < 2; ++b2)
#pragma unroll
      for (int t = 0; t < 4; ++t) {
        const float qs = ps[b2][4 * t] + ps[b2][4 * t + 1] + ps[b2][4 * t + 2] + ps[b2][4 * t + 3];
        const float prev = h ? ol[b2][t] : (t > 0 ? ol[b2][t - 1] : (b2 > 0 ? ol[0][3] : carry));
        const int n = kt * 16 + 8 * b2 + 2 * t + h;
        float val = qs + prev;
        const bool causal = 64 * n <= q, forced = (n == 0) || (n == cur) || (n == cur - 1);
        val = causal ? (forced ? 1e4f : val) : -1.f;
        imp[(32 * w + c) * 132 + n] = val;
      }
    carry = ol[1][3];
  }
  __syncthreads();
  {
    const int t = TID(), ql = t >> 1, hf = t & 1;
    const float* row = imp + ql * 132 + hf * 64;
    unsigned key[64];
#pragma unroll
    for (int i4 = 0; i4 < 16; ++i4) {
      const f32x4 x = *(const f32x4*)(row + 4 * i4);
#pragma unroll
      for (int e = 0; e < 4; ++e) { const unsigned u = __float_as_uint(x[e]); key[4 * i4 + e] = (u & 0x80000000u) ? ~u : (u | 0x80000000u); }
    }
    unsigned T = 0;
#pragma unroll 1
    for (int bit = 31; bit >= 0; --bit) {
      const unsigned cand = T | (1u << bit);
      int cnt = 0;
#pragma unroll
      for (int i = 0; i < 64; ++i) cnt += (key[i] >= cand) ? 1 : 0;
      cnt += __shfl_xor(cnt, 1);
      if (cnt >= 16) T = cand;
    }
    int cgt = 0, eq = 0;
#pragma unroll
    for (int i = 0; i < 64; ++i) { cgt += (key[i] > T) ? 1 : 0; eq += (key[i] == T) ? 1 : 0; }
    const int cgt_o = __shfl_xor(cgt, 1), eq_o = __shfl_xor(eq, 1);
    int r = 16 - (cgt + cgt_o);
    if (hf) r -= eq_o;
    unsigned m0 = 0, m1 = 0;
#pragma unroll
    for (int i = 0; i < 64; ++i) {
      bool sel = key[i] > T;
      if (key[i] == T) { sel = r > 0; --r; }
      if (i < 32) m0 |= sel ? (1u << i) : 0u; else m1 |= sel ? (1u << (i - 32)) : 0u;
    }
    unsigned* selm = (unsigned*)(big + B_SELM) + ((size_t)bh * SEQ + q0 + ql) * 4 + hf * 2;
    u32x2 mv = {m0, m1}; *(u32x2*)selm = mv;
  }
}

DEVI void item_selwin(const Params& p, int b, int head, int qb, char* smem) {
  const int hkv = head >> 2;
  const int lane = TID() & 63, w = TID() >> 6, h = lane >> 5;
  char* big = p.ws + OFF_BIG;
  const int q0 = qb * 128, qa = q0 + 32 * w, q = qa + (lane & 31);
  const size_t tok = (size_t)b * SEQ + q;
  float* lut; float far_; load_lut(p, 8 + head, smem, lut, far_);
  bf16_t* qrow = (bf16_t*)(big + B_NQ) + tok * 512 + head * 64;
  bf16x8 qf[4]; load_qf<4>(qf, qrow, h, 0);
  const u32x4 sm = *(const u32x4*)((const unsigned*)(big + B_SELM) + ((size_t)(b * 2 + hkv) * SEQ + q) * 4);
  const bf16_t* gate = (const bf16_t*)(big + B_NGATE) + tok * 32 + head * 3;
  const float g1 = sigm(bf2f(gate[1])), g2 = sigm(bf2f(gate[2]));
  const float sc = 0.125f * LOG2E;
  f32x16 res[2];
  {
    f32x16 o[2]; o[0] = zero16(); o[1] = zero16();
    float m_ = -__builtin_huge_valf(), l_ = 0.f;
    const bf16_t* kA = (const bf16_t*)(big + B_NKS) + (size_t)b * SEQ * 128 + hkv * 64;
    const bf16_t* vt = (const bf16_t*)(big + B_NVST) + ((size_t)b * 128 + hkv * 64) * SEQ;
    flash_loop<64, 64, 3>(o, m_, l_, qf, kA, 128, nullptr, 0, vt, SEQ, 0, q0 / 64 + 2, q, qa, 1 << 30, lut, far_, sc, sm, smem);
    const float il = frcp(l_ + __shfl_xor(l_, 32)) * g1;
    res[0] = o[0] * il; res[1] = o[1] * il;
  }
  {
    f32x16 o[2]; o[0] = zero16(); o[1] = zero16();
    float m_ = -__builtin_huge_valf(), l_ = 0.f;
    const bf16_t* kA = (const bf16_t*)(big + B_NKW) + (size_t)b * SEQ * 128 + hkv * 64;
    const bf16_t* vt = (const bf16_t*)(big + B_NVWT) + ((size_t)b * 128 + hkv * 64) * SEQ;
    int kt0 = q0 / 64 - 8; if (kt0 < 0) kt0 = 0;
    flash_loop<64, 64, 1>(o, m_, l_, qf, kA, 128, nullptr, 0, vt, SEQ, kt0, q0 / 64 + 2, q, qa, 512, lut, far_, sc, sm, smem);
    const float il = frcp(l_ + __shfl_xor(l_, 32)) * g2;
    res[0] += o[0] * il; res[1] += o[1] * il;
  }
  const bf16_t* oc = (const bf16_t*)(big + B_OC) + tok * 512 + head * 64;
#pragma unroll
  for (int dvb = 0; dvb < 2; ++dvb)
#pragma unroll
    for (int t = 0; t < 4; ++t) {
      const int dv = dvb * 32 + 8 * t + 4 * h;
      const u32x2 ov = *(const u32x2*)(oc + dv);
      const float c0 = __uint_as_float(ov.x << 16), c1 = __uint_as_float(ov.x & 0xffff0000u), c2 = __uint_as_float(ov.y << 16), c3 = __uint_as_float(ov.y & 0xffff0000u);
      u32x2 v; v.x = pk2(res[dvb][4 * t] + c0, res[dvb][4 * t + 1] + c1); v.y = pk2(res[dvb][4 * t + 2] + c2, res[dvb][4 * t + 3] + c3);
      *(u32x2*)(qrow + dv) = v;
    }
}

DEVI void item_mla_expand(const Params& p, int kind, int i, char* smem) {
  char* big = p.ws + OFF_BIG;
  const int tid = TID(), lane = tid & 63, w = tid >> 6, wm = w >> 1, wn = w & 1;
  const int NT = kind ? 8 : 6, mt = i / NT, nt = i % NT, K = kind ? 128 : 256;
  const bf16_t* A = (const bf16_t*)(big + (kind ? B_CKV : B_CQ)) + (size_t)mt * 128 * K;
  const bf16_t* Bt = (const bf16_t*)(p.ws + OFF_W + (kind ? W_UKV : W_UQ)) + (size_t)nt * 128 * K;
  float* sR = (float*)(smem + 73728);
  __syncthreads();
  {
    const int r = tid >> 1, hf = tid & 1, n = K / 2; const bf16_t* rp = A + (size_t)r * K + hf * n; float ss = 0.f;
    for (int j = 0; j < n; j += 8) { const u32x4 v = *(const u32x4*)(rp + j);
#pragma unroll
      for (int e = 0; e < 4; ++e) { const float a = __uint_as_float(v[e] << 16), bq = __uint_as_float(v[e] & 0xffff0000u); ss += a * a + bq * bq; } }
    ss += __shfl_xor(ss, 1);
    if (!hf) sR[r] = rsqrtf(ss / (float)K + 1e-6f);
  }
  const bool swp = (kind == 0) || (wn == 0);
  f32x16 acc[2][2]; zero_acc(acc);
  gemm_core(acc, A, K, 64, Bt, K, K / 64, smem, swp);
#pragma unroll
  for (int mi = 0; mi < 2; ++mi) {
    const int lr0 = wm * 64 + mi * 32; const long row0 = (long)mt * 128 + lr0;
#pragma unroll
    for (int ni = 0; ni < 2; ++ni) {
      f32x16 a = acc[mi][ni];
      const int cb = nt * 4 + wn * 2 + ni;
      if (swp) {
        const float rs = sR[lr0 + (lane & 31)];
#pragma unroll
        for (int reg = 0; reg < 16; ++reg) a[reg] *= rs;
        if (kind == 0) {
          const int head = cb / 3, part = cb % 3;
          if (part < 2) st_rm_s((bf16_t*)(big + B_QN) + head * 64 + part * 32, 512, row0, a, lane);
          else { f32x16 r = rope_blk_s(a, (int)(row0 & (SEQ - 1)), lane); st_rm_s((bf16_t*)(big + B_QR) + head * 32, 256, row0, r, lane); }
        } else {
          const int head = cb >> 2, part = cb & 3;
          st_rm_s((bf16_t*)(big + B_KN) + head * 64 + part * 32, 512, row0, a, lane);
        }
      } else {
#pragma unroll
        for (int reg = 0; reg < 16; ++reg) a[reg] *= sR[lr0 + rowoff(reg, lane >> 5)];
        const int head = cb >> 2, part = cb & 3;
        const int b = (int)(row0 >> 13);
        st_tr((bf16_t*)(big + B_MVT) + ((size_t)b * 512 + head * 64 + (part - 2) * 32) * SEQ, SEQ, (int)(row0 & (SEQ - 1)), a, lane);
      }
    }
  }
}
DEVI float gelu_tanh(float x) {
  const float z = 0.7978845608028654f * (x + 0.044715f * x * x * x);
  const float th = 1.f - 2.f * frcp(1.f + fexp2(2.f * z * LOG2E));
  return 0.5f * x * (1.f + th);
}
DEVI void item_cmp1(const Params& p, int i, char* smem) {
  char* big = p.ws + OFF_BIG;
  const int lane = TID() & 63, w = TID() >> 6, wm = w >> 1, wn = w & 1;
  const int kv = i >> 5, bh = (i >> 2) & 7, mt = i & 3, b = bh >> 1, hkv = bh & 1;
  const bf16_t* A = (const bf16_t*)(big + (kv ? B_NVC : B_NKC)) + ((size_t)b * SEQ + 16 * (mt * 128)) * 128 + hkv * 64;
  const bf16_t* Bt = (const bf16_t*)(p.ws + OFF_W + W_C1) + (size_t)kv * 128 * 2048;
  f32x16 acc[2][2]; zero_acc(acc);
  gemm_core(acc, A, 2048, 128, Bt, 2048, 32, smem);
  const float* cb = (const float*)(p.ws + OFF_MISC + MISC_CBIAS) + kv * 32 * 128;
  bf16_t* hdn = (bf16_t*)(big + B_HDN) + ((size_t)(kv * 8 + bh) * 512) * 128;
#pragma unroll
  for (int mi = 0; mi < 2; ++mi)
#pragma unroll
    for (int ni = 0; ni < 2; ++ni) {
      const int col = wn * 64 + ni * 32 + (lane & 31); float bias = 0.f;
#pragma unroll 8
      for (int ch = 0; ch < 32; ++ch) bias += cb[ch * 128 + col];
      f32x16 a = acc[mi][ni];
#pragma unroll
      for (int reg = 0; reg < 16; ++reg) a[reg] = gelu_tanh(a[reg] + bias);
      st_rm(hdn + wn * 64 + ni * 32, 128, mt * 128 + wm * 64 + mi * 32, a, lane);
    }
}
DEVI void item_cmp2(const Params& p, int i, char* smem) {
  char* big = p.ws + OFF_BIG;
  const int lane = TID() & 63, w = TID() >> 6, wm = w >> 1, wn = w & 1;
  const int kv = i >> 5, mt = i & 31;
  const bf16_t* A = (const bf16_t*)(big + B_HDN) + ((size_t)kv * 4096 + mt * 128) * 128;
  const bf16_t* Bt = (const bf16_t*)(p.ws + OFF_W + W_C2) + (size_t)kv * 128 * 128;
  f32x16 acc[2][2]; zero_acc(acc);
  gemm_core(acc, A, 128, 64, Bt, 128, 2, smem, kv == 0);
  if (wn == 0) {
#pragma unroll
    for (int mi = 0; mi < 2; ++mi)
#pragma unroll
      for (int ni = 0; ni < 2; ++ni) {
        const int row0 = mt * 128 + wm * 64 + mi * 32;
        if (kv == 0) st_rm_s((bf16_t*)(big + B_KCMP) + ni * 32, 64, row0, acc[mi][ni], lane);
        else { const int bh = row0 >> 9; st_tr((bf16_t*)(big + B_VCMPT) + ((size_t)bh * 64 + ni * 32) * 512, 512, row0 & 511, acc[mi][ni], lane); }
      }
  }
}

DEVI void phase_merge(const Params& p, char* smem, bool rev) {
  char* big = p.ws + OFF_BIG;
  const bf16_t* u = (const bf16_t*)(p.ws + OFF_XN);
  const bf16_t* wg = (const bf16_t*)(p.ws + OFF_W + W_G);
  const bf16_t* wb = (const bf16_t*)(p.ws + OFF_W + W_B);
  bf16_t* merged = (bf16_t*)(big + B_MERGED);
  const int NT = 8, ntiles = 128 * NT, lb = logical_block(), G = gridDim.x;
  const int ntl = lb < ntiles ? (ntiles - lb + G - 1) / G : 0;
  auto segfn = [&](int j) {
    int mt, nt; tile_mn(lb + (j >> 3) * G, NT, mt, nt, rev);
    const int sub = j & 7, i = sub >> 1; GSeg2 g; g.swp = true;
    if (!(sub & 1)) { g.A = u + (size_t)mt * 256 * DM; g.lda = DM; g.Bt = wg + ((size_t)i * DM + nt * 128) * DM; g.ldb = DM; g.nk2 = 16; }
    else { const size_t yoff = (i == 0) ? B_QN : (i == 1) ? B_SQ : (i == 2) ? B_NQ : B_DQ;
           g.A = (const bf16_t*)(big + yoff) + (size_t)mt * 256 * 512; g.lda = 512; g.Bt = wb + ((size_t)i * DM + nt * 128) * 512; g.ldb = 512; g.nk2 = 8; }
    return g; };
  auto epi = [&](int j, f32x16 (&acc)[4][2]) {
    const int sub = j & 7, t2 = TID();
    unsigned* gsc = (unsigned*)(big + B_DK) + (size_t)blockIdx.x * 16384 + t2;
    if (!(sub & 1)) {
#pragma unroll
      for (int mi = 0; mi < 4; ++mi)
#pragma unroll
        for (int ni = 0; ni < 2; ++ni)
#pragma unroll
          for (int r = 0; r < 8; ++r) gsc[((mi * 2 + ni) * 8 + r) * 256] = pk2(sigm(acc[mi][ni][2 * r]), sigm(acc[mi][ni][2 * r + 1]));
      return;
    }
    int mt, nt; tile_mn(lb + (j >> 3) * G, NT, mt, nt, rev);
    const int lane = t2 & 63, w = t2 >> 6, wm = w >> 1, wn = w & 1;
#pragma unroll
    for (int mi = 0; mi < 4; ++mi)
#pragma unroll
      for (int ni = 0; ni < 2; ++ni) {
        bf16_t* rp = merged + ((long)mt * 256 + wm * 128 + mi * 32 + (lane & 31)) * DM + nt * 128 + wn * 64 + ni * 32 + 4 * (lane >> 5);
#pragma unroll
        for (int t = 0; t < 4; ++t) {
          const unsigned g0 = gsc[((mi * 2 + ni) * 8 + 2 * t) * 256], g1 = gsc[((mi * 2 + ni) * 8 + 2 * t + 1) * 256];
          float v0 = __uint_as_float(g0 << 16) * acc[mi][ni][4 * t], v1 = __uint_as_float(g0 & 0xffff0000u) * acc[mi][ni][4 * t + 1];
          float v2 = __uint_as_float(g1 << 16) * acc[mi][ni][4 * t + 2], v3 = __uint_as_float(g1 & 0xffff0000u) * acc[mi][ni][4 * t + 3];
          if (sub != 1) {
            const u32x2 o = *(const u32x2*)(rp + 8 * t);
            v0 += __uint_as_float(o.x << 16); v1 += __uint_as_float(o.x & 0xffff0000u); v2 += __uint_as_float(o.y << 16); v3 += __uint_as_float(o.y & 0xffff0000u);
          }
          u32x2 v; v.x = pk2(v0, v1); v.y = pk2(v2, v3); *(u32x2*)(rp + 8 * t) = v;
        }
      }
  };
  gemm_stream2(ntl * 8, segfn, epi, smem);
}

DEVI unsigned xb_ld(unsigned* p) { return __hip_atomic_load(p, __ATOMIC_RELAXED, __HIP_MEMORY_SCOPE_AGENT); }
DEVI unsigned xb_add(unsigned* p, unsigned v) { return __hip_atomic_fetch_add(p, v, __ATOMIC_RELAXED, __HIP_MEMORY_SCOPE_AGENT); }
DEVI unsigned xb_xcc_id() { return (unsigned)__builtin_amdgcn_s_getreg((3 << 11) | 20) & 0xFu; }
DEVI void xb_census_post(unsigned* bar, char* smem) {
  if (TID() == 0) { volatile unsigned* st = (volatile unsigned*)(smem + SMEM_BYTES - 12); const unsigned x = xb_xcc_id(); st[2] = x; st[0] = 0; st[1] = 0; (void)xb_add(&bar[64 * x], 1u); }
}
DEVI void xb_census_complete(unsigned* bar, char* smem) {
  if (TID() == 0) {
    volatile unsigned* st = (volatile unsigned*)(smem + SMEM_BYTES - 12);
    const unsigned x = st[2], G = gridDim.x;
    unsigned mine = 0, cnt = 0, sum = 0, sp = 0;
    for (;;) {
      sum = 0; cnt = 0; mine = 0;
      for (unsigned j = 0; j < 16; ++j) { const unsigned c = xb_ld(&bar[64 * j]); sum += c; cnt += (c > 0u) ? 1u : 0u; mine = (j == x) ? c : mine; }
      if (sum == G || ++sp > (1u << 22)) break;
      __builtin_amdgcn_s_sleep(1);
    }
    st[0] = mine > 0u ? mine : 1u; st[1] = cnt > 0u ? cnt : 1u;
  }
  __syncthreads();
}
DEVI void xb_barrier(unsigned* bar, char* smem) {
  asm volatile("s_waitcnt vmcnt(0)" ::: "memory");
  __syncthreads();
  if (TID() == 0) {
    asm volatile("s_waitcnt vmcnt(0) lgkmcnt(0)" ::: "memory");
    volatile unsigned* st = (volatile unsigned*)(smem + SMEM_BYTES - 12);
    const unsigned nloc = st[0], nx = st[1], x = st[2];
    const unsigned old = xb_add(&bar[1024 + 64 * x], 1u), gen = old / nloc;
    if (old + 1u == (gen + 1u) * nloc) {
      __builtin_amdgcn_fence(__ATOMIC_RELEASE, "agent");
      asm volatile("s_waitcnt vmcnt(0)" ::: "memory");
      const unsigned og = xb_add(&bar[3072], 1u), tg = og / nx;
      if (og + 1u == (tg + 1u) * nx) xb_add(&bar[3136], 1u);
      else { unsigned sp = 0; while (xb_ld(&bar[3136]) == tg && ++sp < (1u << 24)) __builtin_amdgcn_s_sleep(1); }
      __builtin_amdgcn_fence(__ATOMIC_ACQUIRE, "agent");
      xb_add(&bar[2048 + 64 * x], 1u);
      asm volatile("s_waitcnt vmcnt(0)" ::: "memory");
    } else {
      unsigned sp = 0; while (xb_ld(&bar[2048 + 64 * x]) == gen && ++sp < (1u << 24)) __builtin_amdgcn_s_sleep(1);
      __builtin_amdgcn_fence(__ATOMIC_ACQUIRE, "agent");
      asm volatile("s_waitcnt vmcnt(0)" ::: "memory");
    }
  }
  __syncthreads();
}

DEVI void run_phase(const Params& p_in, int ph, char* smem, int dup = 0) {
  Params p = p_in;
  {
    size_t z = 0; asm volatile("" : "+s"(z));
    p.x += z; p.norm_g += z; p.w_in += z; p.mla_q_norm += z; p.mla_kv_norm += z; p.mla_w_uq += z; p.mla_w_ukv += z; p.swa_sinks += z; p.cmp_pos += z;
    p.cmp_w1 += z; p.cmp_w2 += z; p.diff_lambda += z; p.diff_subln += z; p.rel_bias += z; p.w_branch += z; p.w_gate += z; p.w_o += z; p.ffn_w_gate += z;
    p.ffn_w_up += z; p.ffn_w_down += z; p.final_g += z; p.out += z; p.ws += z;
  }
  char* big = p.ws + OFF_BIG;
  const int xcd = blockIdx.x & 7;
  int* ctr = (int*)(p.ws + OFF_MISC + MISC_CTR) + ((ph + 32 * dup) * 8 + xcd) * 16;
  if (ph == 28) {
    for (int it = logical_block(); it < MTOK / 16; it += gridDim.x) norm_rows(p.out, p.final_g, nullptr, p.out, MTOK / 16 - 1 - it);
    return;
  }
  const int l = ph / 14, s = ph % 14;
  const bool rev = (s & 1) == 0;
#ifdef ONLY
  if (s != ONLY) return;
#endif
#ifdef SKIP_MIXER
  if (s >= 3 && s <= 10) return;
#endif
  switch (s) {
    case 0: phase_norm_conv(p, l, 0, smem, rev); break;
    case 1: phase_ffn_up(p, smem, rev); break;
    case 2: gemm_resid_phase((const bf16_t*)(big + B_ACT), DFF, 44, (const bf16_t*)(p.ws + OFF_W + W_D), l == 0 ? p.x : p.out, p.out, 0.5f, smem, rev); break;
    case 3: phase_norm_conv(p, l, 1, smem, rev); break;
    case 4: phase_win(p, smem, rev); break;
    case 5: {
      for (;;) { const int it = fetch_item(ctr, smem); if (it >= 712) break;
        if (it < 8) item_cmp1(p, xcd * 8 + it, smem); else if (it < 200) item_mla_expand(p, 0, xcd * 192 + it - 8, smem);
        else if (it < 456) item_mla_expand(p, 1, xcd * 256 + it - 200, smem);
        else { const int j = it - 456; item_swa(p, l, xcd >> 1, (xcd & 1) * 4 + (j & 3), 63 - (j >> 2), smem); } }
    } break;
    case 6: {
      for (;;) { const int it = fetch_item(ctr, smem); if (it >= 136) break;
        if (it < 128) { const int pr = 2 * xcd + (it & 1); item_diff(p, l, pr >> 2, pr & 3, 63 - (it >> 1), smem); } else item_cmp2(p, xcd * 8 + it - 128, smem); }
    } break;
    case 7: {
      for (;;) { const int it = fetch_item(ctr, smem); if (it >= 320) break;
        if (it < 64) item_cmp(p, xcd, 63 - it, smem);
        else { const int j = it - 64; item_mla(p, xcd >> 1, (xcd & 1) * 4 + (j & 3), 63 - (j >> 2), smem); } }
    } break;
    case 8: {
      for (;;) { const int it = fetch_item(ctr, smem); if (it >= 256) break; item_selwin(p, xcd >> 1, (xcd & 1) * 4 + (it & 3), 63 - (it >> 2), smem); }
    } break;
    case 9: phase_merge(p, smem, rev); break;
    case 10: gemm_resid_phase((const bf16_t*)(big + B_MERGED), DM, 16, (const bf16_t*)(p.ws + OFF_W + W_O), p.out, p.out, 1.0f, smem, rev); break;
    case 11: phase_norm_conv(p, l, 2, smem, rev); break;
    case 12: phase_ffn_up(p, smem, rev); break;
    case 13: gemm_resid_phase((const bf16_t*)(big + B_ACT), DFF, 44, (const bf16_t*)(p.ws + OFF_W + W_D), p.out, p.out, 0.5f, smem, rev); break;
  }
}

__global__ void __launch_bounds__(256, 2) hybrid_fwd(Params p, int ph_lo, int ph_hi) {
  __shared__ __attribute__((aligned(16))) char smem[SMEM_BYTES];
#if ONE_LAUNCH
  cg::grid_group grid = cg::this_grid();
#endif
  int dup = 0;
#if ONE_LAUNCH
  unsigned* bar = (unsigned*)(p.ws + OFF_MISC + MISC_BAR);
  xb_census_post(bar, smem);
  bool first = true;
#endif
  for (int ph = ph_lo; ph < ph_hi; ++ph) {
    run_phase(p, ph, smem, dup);
#if ONE_LAUNCH
    if (ph + 1 < ph_hi) {
      if (first) { xb_census_complete(bar, smem); first = false; }
      xb_barrier(bar, smem);
      if (ph_hi > 1000) grid.sync();
    }
#endif
#ifdef PROBE_DUP_HI
    if (ph < 28 && ph % 14 == PROBE_DUP_HI) { if (!dup) { dup = 1; ph -= (PROBE_DUP_HI - PROBE_DUP_LO + 1); } else dup = 0; }
#endif
  }
}

extern "C" void kernel_launch(void* const* d_in, const int* in_sizes, int n_in, void* d_out, int out_size, void* d_ws, size_t ws_size,
                              hipStream_t stream) {
  (void)in_sizes; (void)n_in; (void)out_size;
  if (ws_size < WS_NEED) { fprintf(stderr, "workspace too small: %zu < %zu\n", ws_size, (size_t)WS_NEED); return; }
  Params p{};
  const float** f = (const float**)&p;
  for (int i = 0; i < 21; ++i) f[i] = (const float*)d_in[i];
  p.out = (float*)d_out; p.ws = (char*)d_ws;
  static int grid_blocks = 0;
  if (!grid_blocks) {
    int dev = 0, cus = 0, per_cu = 0;
    hipGetDevice(&dev);
    hipDeviceGetAttribute(&cus, hipDeviceAttributeMultiprocessorCount, dev);
    hipOccupancyMaxActiveBlocksPerMultiprocessor(&per_cu, hybrid_fwd, 256, 0);
    if (per_cu > 2) per_cu = 2;
    grid_blocks = cus * per_cu;
    grid_blocks -= grid_blocks % 8;
  }
  hipMemsetAsync((char*)d_ws + OFF_MISC + MISC_CTR, 0, MISC_ZERO_BYTES, stream);
#if ONE_LAUNCH
  int lo = 0, hi = NPHASE;
  void* args[] = {&p, &lo, &hi};
  hipError_t e = hipLaunchCooperativeKernel((void*)hybrid_fwd, dim3(grid_blocks), dim3(256), args, 0, stream);
  if (e != hipSuccess) fprintf(stderr, "cooperative launch failed: %s (grid %d)\n", hipGetErrorString(e), grid_blocks);
#else
  for (int ph = 0; ph < NPHASE; ++ph) hipLaunchKernelGGL(hybrid_fwd, dim3(grid_blocks), dim3(256), 0, stream, p, ph, ph + 1);
#endif
}
```

```cpp
#include <hip/hip_runtime.h>
#include <hip/hip_cooperative_groups.h>
#include <cstdio>
#include <cstdint>
namespace cg = cooperative_groups;

#ifndef ONE_LAUNCH
#define ONE_LAUNCH 1
#endif

typedef unsigned short bf16_t;
typedef short bf16x8 __attribute__((ext_vector_type(8)));
typedef float f32x16 __attribute__((ext_vector_type(16)));
typedef float f32x4 __attribute__((ext_vector_type(4)));
typedef unsigned u32x4 __attribute__((ext_vector_type(4)));
typedef unsigned u32x2 __attribute__((ext_vector_type(2)));

#define DEVI __device__ __forceinline__
__device__ __forceinline__ int threadIdx_x_raw() { return (int)__builtin_amdgcn_workitem_id_x(); }

constexpr int MTOK = 32768, SEQ = 8192, DM = 1024, DFF = 2816;
constexpr float LOG2E = 1.4426950408889634f;
constexpr int SMEM_BYTES = 79872;
constexpr int NPHASE = 29;

constexpr size_t MiB = 1u << 20;
constexpr size_t OFF_W = 0;
constexpr size_t OFF_MISC = 24 * MiB;
constexpr size_t OFF_XN = 25 * MiB;
constexpr size_t OFF_BIG = 89 * MiB;
constexpr size_t OFF_SCR = 489 * MiB;
constexpr size_t WS_NEED = 505 * MiB;
constexpr size_t W_GU = 0, W_D = 11534336;
constexpr size_t W_IN = 0, W_G = 8 * MiB, W_B = 16 * MiB, W_O = 20 * MiB, W_UQ = 22 * MiB, W_UKV = 22 * MiB + 512 * 1024,
                 W_C1 = 22 * MiB + 768 * 1024, W_C2 = 23 * MiB + 768 * 1024;
constexpr size_t MISC_CTR = 0, MISC_BAR = 32768, MISC_LUT = 49152, MISC_CBIAS = 65536;
constexpr size_t MISC_ZERO_BYTES = 49152;
constexpr size_t B_ACT = 0;
constexpr size_t B_CQ = 0, B_CKV = 16 * MiB, B_KROPE = 24 * MiB, B_NGATE = 26 * MiB, B_SQ = 28 * MiB, B_SK = 60 * MiB, B_SVT = 68 * MiB,
                 B_NQ = 76 * MiB, B_NKC = 108 * MiB, B_NVC = 116 * MiB, B_NKS = 124 * MiB, B_NVST = 132 * MiB, B_NKW = 140 * MiB,
                 B_NVWT = 148 * MiB, B_DQ = 156 * MiB, B_DK = 188 * MiB, B_DVT = 220 * MiB, B_QN = 252 * MiB, B_QR = 284 * MiB,
                 B_KN = 300 * MiB, B_MVT = 332 * MiB, B_OC = 364 * MiB, B_HDN = 396 * MiB, B_KCMP = 398 * MiB,
                 B_VCMPT = 398 * MiB + 512 * 1024, B_SELM = 399 * MiB, B_MERGED = B_KN;

struct Params {
  const float *x, *norm_g, *w_in, *mla_q_norm, *mla_kv_norm, *mla_w_uq, *mla_w_ukv, *swa_sinks, *cmp_pos, *cmp_w1, *cmp_w2,
      *diff_lambda, *diff_subln, *rel_bias, *w_branch, *w_gate, *w_o, *ffn_w_gate, *ffn_w_up, *ffn_w_down, *final_g;
  float* out;
  char* ws;
};

struct Seg { int blk0, nblk, src_col, ld, mode; unsigned off_kib; };
__constant__ Seg c_segs[18] = {
  {0, 8, 0, 256, 0, (unsigned)(B_CQ >> 10)},      {8, 4, 256, 128, 0, (unsigned)(B_CKV >> 10)},   {12, 1, 384, 32, 2, (unsigned)(B_KROPE >> 10)},
  {13, 1, 2464, 32, 0, (unsigned)(B_NGATE >> 10)}, {14, 2, -1, 0, 3, 0},                           {16, 16, 416, 512, 0, (unsigned)(B_SQ >> 10)},
  {32, 4, 928, 128, 0, (unsigned)(B_SK >> 10)},   {36, 4, 1056, 128, 1, (unsigned)(B_SVT >> 10)}, {40, 16, 1184, 512, 0, (unsigned)(B_NQ >> 10)},
  {56, 4, 1696, 128, 0, (unsigned)(B_NKC >> 10)}, {60, 4, 1824, 128, 0, (unsigned)(B_NVC >> 10)}, {64, 4, 1952, 128, 0, (unsigned)(B_NKS >> 10)},
  {68, 4, 2080, 128, 1, (unsigned)(B_NVST >> 10)}, {72, 4, 2208, 128, 0, (unsigned)(B_NKW >> 10)}, {76, 4, 2336, 128, 1, (unsigned)(B_NVWT >> 10)},
  {80, 16, 2488, 512, 0, (unsigned)(B_DQ >> 10)}, {96, 16, 3000, 512, 0, (unsigned)(B_DK >> 10)}, {112, 16, 3512, 512, 1, (unsigned)(B_DVT >> 10)}};

DEVI int find_seg(int blk) {
  int s = 0;
#pragma unroll
  for (int i = 1; i < 18; ++i) if (blk >= c_segs[i].blk0) s = i;
  return s;
}

typedef float f32x2_t __attribute__((ext_vector_type(2)));
typedef __bf16 bf16x2_t __attribute__((ext_vector_type(2)));
DEVI unsigned pk2(float a, float b) { f32x2_t v = {a, b}; bf16x2_t r = __builtin_convertvector(v, bf16x2_t); return __builtin_bit_cast(unsigned, r); }
DEVI bf16_t f2bf(float a) { return (bf16_t)(pk2(a, 0.f) & 0xffffu); }
DEVI float bf2f(bf16_t v) { return __uint_as_float(((unsigned)v) << 16); }
DEVI float fexp2(float x) { return __builtin_amdgcn_exp2f(x); }
DEVI float frcp(float x) { return __builtin_amdgcn_rcpf(x); }
DEVI float sigm(float x) { return frcp(1.f + fexp2(-x * LOG2E)); }
DEVI f32x16 mfma32(bf16x8 a, bf16x8 b, f32x16 c) { return __builtin_amdgcn_mfma_f32_32x32x16_bf16(a, b, c, 0, 0, 0); }
DEVI float wave_sum(float v) {
#pragma unroll
  for (int o = 32; o >= 1; o >>= 1) v += __shfl_xor(v, o);
  return v;
}
DEVI int TID() { int t = threadIdx_x_raw(); asm volatile("" : "+v"(t)); return t; }
DEVI int rowoff(int reg, int h) { return (reg & 3) + 8 * (reg >> 2) + 4 * h; }
DEVI f32x16 zero16() { f32x16 z;
#pragma unroll
  for (int i = 0; i < 16; ++i) z[i] = 0.f; return z; }

DEVI int fetch_item(int* ctr, char* smem) {
  int* slot = (int*)(smem + SMEM_BYTES - 16);
  __syncthreads();
  if (TID() == 0) *slot = atomicAdd(ctr, 1);
  __syncthreads();
  return *slot;
}
DEVI int logical_block() { return (blockIdx.x & 7) * (gridDim.x >> 3) + (blockIdx.x >> 3); }

template <bool LOWREG = false>
DEVI void gemm_core(f32x16 (&acc)[2][2], const bf16_t* __restrict__ A, long lda, long a_kstep, const bf16_t* __restrict__ Bt, long ldb,
                    int nk, char* smem, bool swp = false) {
  const int tid = TID(), lane = tid & 63, w = tid >> 6, wm = w >> 1, wn = w & 1;
  bf16_t* sA = (bf16_t*)smem;
  bf16_t* sB = sA + 2 * 128 * 72;
  const int lr = tid >> 3, lc = (tid & 7) * 8;
  const bf16_t* ap = A + (long)lr * lda + lc;
  const bf16_t* bp = Bt + (long)lr * ldb + lc;
  const bf16_t* a_ = sA + (wm * 64 + (lane & 31)) * 72 + (lane >> 5) * 8;
  const bf16_t* b_ = sB + (wn * 64 + (lane & 31)) * 72 + (lane >> 5) * 8;
  auto gload = [&](u32x4 (&ra)[4], u32x4 (&rb)[4], int kt) {
#pragma unroll
    for (int i = 0; i < 4; ++i) {
      ra[i] = *(const u32x4*)(ap + (long)(32 * i) * lda + (long)kt * a_kstep);
      rb[i] = *(const u32x4*)(bp + (long)(32 * i) * ldb + (long)kt * 64);
    }
  };
  auto swrite = [&](const u32x4 (&ra)[4], const u32x4 (&rb)[4], int buf) {
#pragma unroll
    for (int i = 0; i < 4; ++i) { *(u32x4*)(sA + buf * 128 * 72 + (lr + 32 * i) * 72 + lc) = ra[i]; *(u32x4*)(sB + buf * 128 * 72 + (lr + 32 * i) * 72 + lc) = rb[i]; }
  };
  auto compute = [&](int buf) {
#pragma unroll
    for (int ks = 0; ks < 4; ++ks) {
      bf16x8 a0 = *(const bf16x8*)(a_ + buf * 128 * 72 + ks * 16), a1 = *(const bf16x8*)(a_ + buf * 128 * 72 + 32 * 72 + ks * 16);
      bf16x8 b0 = *(const bf16x8*)(b_ + buf * 128 * 72 + ks * 16), b1 = *(const bf16x8*)(b_ + buf * 128 * 72 + 32 * 72 + ks * 16);
      if (swp) {
        acc[0][0] = mfma32(b0, a0, acc[0][0]); acc[0][1] = mfma32(b1, a0, acc[0][1]);
        acc[1][0] = mfma32(b0, a1, acc[1][0]); acc[1][1] = mfma32(b1, a1, acc[1][1]);
      } else {
        acc[0][0] = mfma32(a0, b0, acc[0][0]); acc[0][1] = mfma32(a0, b1, acc[0][1]);
        acc[1][0] = mfma32(a1, b0, acc[1][0]); acc[1][1] = mfma32(a1, b1, acc[1][1]);
      }
    }
  };
  __syncthreads();
  if (LOWREG) {
    u32x4 ra[4], rb[4];
    gload(ra, rb, 0); swrite(ra, rb, 0);
    __syncthreads();
    for (int kt = 0; kt < nk; ++kt) {
      const int buf = kt & 1;
      if (kt + 1 < nk) gload(ra, rb, kt + 1);
      compute(buf);
      if (kt + 1 < nk) swrite(ra, rb, buf ^ 1);
      __syncthreads();
    }
  } else {
    u32x4 ra0[4], rb0[4], ra1[4], rb1[4];
    gload(ra0, rb0, 0); swrite(ra0, rb0, 0);
    if (nk > 1) gload(ra1, rb1, 1);
    __syncthreads();
    for (int kt = 0; kt < nk; kt += 2) {
      if (kt + 2 < nk) gload(ra0, rb0, kt + 2);
      compute(0);
      if (kt + 1 < nk) swrite(ra1, rb1, 1);
      __syncthreads();
      if (kt + 1 >= nk) break;
      if (kt + 3 < nk) gload(ra1, rb1, kt + 3);
      compute(1);
      if (kt + 2 < nk) swrite(ra0, rb0, 0);
      __syncthreads();
    }
  }
}
DEVI void zero_acc(f32x16 (&acc)[2][2]) { acc[0][0] = zero16(); acc[0][1] = zero16(); acc[1][0] = zero16(); acc[1][1] = zero16(); }
DEVI void tile_mn(int t, int NT, int& mt, int& nt, bool rev = false) { const int g = t / (2 * NT), r = t % (2 * NT); mt = 2 * g + (r & 1); nt = r >> 1; if (rev) mt = 127 - mt; }


struct GSeg { const bf16_t* A; long lda; long akstep; const bf16_t* Bt; long ldb; int nk; bool swp; };
template <bool ONESET = false, class SegFn, class EpiFn>
DEVI void gemm_stream(int nseg, SegFn segfn, EpiFn epi, char* smem) {
  if (nseg <= 0) return;
  const int tid = TID(), lane = tid & 63, w = tid >> 6, wm = w >> 1, wn = w & 1;
  bf16_t* sA = (bf16_t*)smem;
  bf16_t* sB = sA + 2 * 128 * 72;
  const int lr = tid >> 3, lc = (tid & 7) * 8;
  const bf16_t* a_ = sA + (wm * 64 + (lane & 31)) * 72 + (lane >> 5) * 8;
  const bf16_t* b_ = sB + (wn * 64 + (lane & 31)) * 72 + (lane >> 5) * 8;
  GSeg ls = segfn(0);
  int lj = 0, lk = 0;
  const bf16_t* ap = ls.A + (long)lr * ls.lda + lc;
  const bf16_t* bp = ls.Bt + (long)lr * ls.ldb + lc;
  auto advance_load = [&](u32x4 (&ra)[4], u32x4 (&rb)[4]) {
    if (lj >= nseg) return;
#pragma unroll
    for (int i = 0; i < 4; ++i) {
      ra[i] = *(const u32x4*)(ap + (long)(32 * i) * ls.lda + (long)lk * ls.akstep);
      rb[i] = *(const u32x4*)(bp + (long)(32 * i) * ls.ldb + (long)lk * 64);
    }
    if (++lk == ls.nk) { lk = 0; ++lj; if (lj < nseg) { ls = segfn(lj); ap = ls.A + (long)lr * ls.lda + lc; bp = ls.Bt + (long)lr * ls.ldb + lc; } }
  };
  auto swrite = [&](const u32x4 (&ra)[4], const u32x4 (&rb)[4], int buf) {
#pragma unroll
    for (int i = 0; i < 4; ++i) { *(u32x4*)(sA + buf * 128 * 72 + (lr + 32 * i) * 72 + lc) = ra[i]; *(u32x4*)(sB + buf * 128 * 72 + (lr + 32 * i) * 72 + lc) = rb[i]; }
  };
  f32x16 acc[2][2]; zero_acc(acc);
  bool cswp = ls.swp;
  auto compute = [&](int buf) {
#pragma unroll
    for (int ks = 0; ks < 4; ++ks) {
      bf16x8 a0 = *(const bf16x8*)(a_ + buf * 128 * 72 + ks * 16), a1 = *(const bf16x8*)(a_ + buf * 128 * 72 + 32 * 72 + ks * 16);
      bf16x8 b0 = *(const bf16x8*)(b_ + buf * 128 * 72 + ks * 16), b1 = *(const bf16x8*)(b_ + buf * 128 * 72 + 32 * 72 + ks * 16);
      if (cswp) {
        acc[0][0] = mfma32(b0, a0, acc[0][0]); acc[0][1] = mfma32(b1, a0, acc[0][1]);
        acc[1][0] = mfma32(b0, a1, acc[1][0]); acc[1][1] = mfma32(b1, a1, acc[1][1]);
      } else {
        acc[0][0] = mfma32(a0, b0, acc[0][0]); acc[0][1] = mfma32(a0, b1, acc[0][1]);
        acc[1][0] = mfma32(a1, b0, acc[1][0]); acc[1][1] = mfma32(a1, b1, acc[1][1]);
      }
    }
  };
  if (ONESET) {
    u32x4 ra[4], rb[4];
    __syncthreads();
    advance_load(ra, rb); swrite(ra, rb, 0); advance_load(ra, rb);
    __syncthreads();
    int cj = 0, ck = 0, cnk = segfn(0).nk, par = 0;
    while (cj < nseg) {
      compute(par);
      if (++ck == cnk) { epi(cj, acc); zero_acc(acc); ck = 0; ++cj; if (cj < nseg) { const GSeg ns = segfn(cj); cnk = ns.nk; cswp = ns.swp; } }
      if (cj < nseg) { swrite(ra, rb, par ^ 1); advance_load(ra, rb); }
      par ^= 1;
      __syncthreads();
    }
    return;
  }
  u32x4 ra0[4], rb0[4], ra1[4], rb1[4];
  advance_load(ra0, rb0); advance_load(ra1, rb1);
  __syncthreads();
  swrite(ra0, rb0, 0); advance_load(ra0, rb0);
  __syncthreads();
  int cj = 0, ck = 0, cnk = segfn(0).nk;
  while (cj < nseg) {
    compute(0);
    swrite(ra1, rb1, 1); advance_load(ra1, rb1);
    __syncthreads();
    compute(1);
    ck += 2;
    if (ck == cnk) { epi(cj, acc); zero_acc(acc); ck = 0; ++cj; if (cj < nseg) { const GSeg ns = segfn(cj); cnk = ns.nk; cswp = ns.swp; } }
    if (cj < nseg) { swrite(ra0, rb0, 0); advance_load(ra0, rb0); }
    __syncthreads();
  }
}


struct GSeg2 { const bf16_t* A; long lda; const bf16_t* Bt; long ldb; int nk2; bool swp; };
DEVI void zero_acc2(f32x16 (&acc)[4][2]) {
#pragma unroll
  for (int i = 0; i < 4; ++i) { acc[i][0] = zero16(); acc[i][1] = zero16(); }
}
template <class SegFn, class EpiFn>
DEVI void gemm_stream2(int nseg, SegFn segfn, EpiFn epi, char* smem) {
  if (nseg <= 0) return;
  const int tid = TID(), lane = tid & 63, w = tid >> 6, wm = w >> 1, wn = w & 1;
  bf16_t* sA = (bf16_t*)smem;
  bf16_t* sB = sA + 256 * 72;
  const int lr = tid >> 3, lc = (tid & 7) * 8;
  const bf16_t* a_ = sA + (wm * 128 + (lane & 31)) * 72 + (lane >> 5) * 8;
  const bf16_t* b_ = sB + (wn * 64 + (lane & 31)) * 72 + (lane >> 5) * 8;
  GSeg2 ls = segfn(0);
  int lj = 0, lk = 0;
  const bf16_t* ap = ls.A + (long)lr * ls.lda + lc;
  const bf16_t* bp = ls.Bt + (long)lr * ls.ldb + lc;
  u32x4 ra[8], rb[4];
  auto advance_load = [&]() {
    if (lj >= nseg) return;
#pragma unroll
    for (int i = 0; i < 8; ++i) ra[i] = *(const u32x4*)(ap + (long)(32 * i) * ls.lda + (long)lk * 64);
#pragma unroll
    for (int i = 0; i < 4; ++i) rb[i] = *(const u32x4*)(bp + (long)(32 * i) * ls.ldb + (long)lk * 64);
    if (++lk == ls.nk2) { lk = 0; ++lj; if (lj < nseg) { ls = segfn(lj); ap = ls.A + (long)lr * ls.lda + lc; bp = ls.Bt + (long)lr * ls.ldb + lc; } }
  };
  auto swrite = [&]() {
#pragma unroll
    for (int i = 0; i < 8; ++i) *(u32x4*)(sA + (lr + 32 * i) * 72 + lc) = ra[i];
#pragma unroll
    for (int i = 0; i < 4; ++i) *(u32x4*)(sB + (lr + 32 * i) * 72 + lc) = rb[i];
  };
  f32x16 acc[4][2]; zero_acc2(acc);
  bool cswp = ls.swp;
  auto compute = [&]() {
#pragma unroll
    for (int ks = 0; ks < 4; ++ks) {
      bf16x8 af[4], bfr[2];
#pragma unroll
      for (int mi = 0; mi < 4; ++mi) af[mi] = *(const bf16x8*)(a_ + mi * 32 * 72 + ks * 16);
#pragma unroll
      for (int ni = 0; ni < 2; ++ni) bfr[ni] = *(const bf16x8*)(b_ + ni * 32 * 72 + ks * 16);
      if (cswp) {
#pragma unroll
        for (int mi = 0; mi < 4; ++mi) { acc[mi][0] = mfma32(bfr[0], af[mi], acc[mi][0]); acc[mi][1] = mfma32(bfr[1], af[mi], acc[mi][1]); }
      } else {
#pragma unroll
        for (int mi = 0; mi < 4; ++mi) { acc[mi][0] = mfma32(af[mi], bfr[0], acc[mi][0]); acc[mi][1] = mfma32(af[mi], bfr[1], acc[mi][1]); }
      }
    }
  };
  advance_load();
  int cj = 0, ck = 0, cnk;
  { const GSeg2 s0 = segfn(0); cnk = s0.nk2; cswp = s0.swp; }
  while (cj < nseg) {
    __syncthreads();
    swrite();
    advance_load();
    __syncthreads();
    __builtin_amdgcn_s_setprio(2);
    compute();
    __builtin_amdgcn_s_setprio(0);
    if (++ck == cnk) { epi(cj, acc); zero_acc2(acc); ck = 0; ++cj; if (cj < nseg) { const GSeg2 ns = segfn(cj); cnk = ns.nk2; cswp = ns.swp; } }
  }
}

DEVI void st_rm(bf16_t* dst, long ld, long row0, const f32x16& a, int lane) {
  const int c = lane & 31, h = lane >> 5;
#pragma unroll
  for (int reg = 0; reg < 16; ++reg) dst[(row0 + rowoff(reg, h)) * ld + c] = f2bf(a[reg]);
}
DEVI void st_tr(bf16_t* dstT, long ldt, int s0, const f32x16& a, int lane) {
  const int c = lane & 31, h = lane >> 5;
#pragma unroll
  for (int t = 0; t < 4; ++t) {
    u32x2 v; v.x = pk2(a[4 * t], a[4 * t + 1]); v.y = pk2(a[4 * t + 2], a[4 * t + 3]);
    *(u32x2*)(dstT + (long)c * ldt + s0 + 8 * t + 4 * h) = v;
  }
}

DEVI void st_rm_s(bf16_t* dst, long ld, long tok0, const f32x16& a, int lane) {
  bf16_t* rp = dst + (tok0 + (lane & 31)) * ld + 4 * (lane >> 5);
#pragma unroll
  for (int t = 0; t < 4; ++t) { u32x2 v; v.x = pk2(a[4 * t], a[4 * t + 1]); v.y = pk2(a[4 * t + 2], a[4 * t + 3]); *(u32x2*)(rp + 8 * t) = v; }
}
DEVI void st_tr_s(bf16_t* dstT, long ldt, int s0, const f32x16& a, int lane) {
  bf16_t* cp = dstT + s0 + (lane & 31);
  const int h = lane >> 5;
#pragma unroll
  for (int reg = 0; reg < 16; ++reg) cp[(long)rowoff(reg, h) * ldt] = f2bf(a[reg]);
}
DEVI f32x16 rope_blk_s(const f32x16& a, int pos0, int lane) {
  const int h = lane >> 5; const float pos = (float)(pos0 + (lane & 31));
  f32x16 r;
#pragma unroll
  for (int reg = 0; reg < 8; ++reg) {
    const float fr = fexp2(-(float)rowoff(reg, h) * 0.8304820237218406f);
    const float ang = pos * fr;
    double rv = (double)ang * 0.15915494309189535; rv -= floor(rv);
    const float f = (float)rv, sn = __builtin_amdgcn_sinf(f), cs = __builtin_amdgcn_cosf(f);
    const float x1 = a[reg], x2 = a[reg + 8];
    r[reg] = x1 * cs - x2 * sn; r[reg + 8] = x1 * sn + x2 * cs;
  }
  return r;
}
DEVI f32x16 rope_blk(const f32x16& a, int s0, int lane) {
  const int c = lane & 31, h = lane >> 5;
  const float fr = fexp2(-(float)(c & 15) * 0.8304820237218406f);
  f32x16 r;
#pragma unroll
  for (int reg = 0; reg < 16; ++reg) {
    const float v = a[reg], pv = __shfl_xor(v, 16);
    const float ang = (float)(s0 + rowoff(reg, h)) * fr;
    double rv = (double)ang * 0.15915494309189535; rv -= floor(rv);
    const float f = (float)rv, sn = __builtin_amdgcn_sinf(f), cs = __builtin_amdgcn_cosf(f);
    r[reg] = (c < 16) ? (v * cs - pv * sn) : (pv * sn + v * cs);
  }
  return r;
}

DEVI void norm_rows(const float* __restrict__ src, const float* __restrict__ g, bf16_t* dst, float* dstf, int item) {
  const int lane = TID() & 63, w = TID() >> 6;
  const long row0 = (long)item * 16 + w * 4;
  f32x4 v[4][4];
#pragma unroll
  for (int r = 0; r < 4; ++r)
#pragma unroll
    for (int j = 0; j < 4; ++j) v[r][j] = *(const f32x4*)(src + (row0 + r) * DM + j * 256 + lane * 4);
  f32x4 gv[4];
#pragma unroll
  for (int j = 0; j < 4; ++j) gv[j] = *(const f32x4*)(g + j * 256 + lane * 4);
#pragma unroll
  for (int r = 0; r < 4; ++r) {
    float ss = 0.f;
#pragma unroll
    for (int j = 0; j < 4; ++j) ss += v[r][j][0] * v[r][j][0] + v[r][j][1] * v[r][j][1] + v[r][j][2] * v[r][j][2] + v[r][j][3] * v[r][j][3];
    ss = wave_sum(ss);
    const float rstd = rsqrtf(ss * (1.f / DM) + 1e-6f);
#pragma unroll
    for (int j = 0; j < 4; ++j) {
      const float o0 = v[r][j][0] * rstd * gv[j][0], o1 = v[r][j][1] * rstd * gv[j][1], o2 = v[r][j][2] * rstd * gv[j][2], o3 = v[r][j][3] * rstd * gv[j][3];
      if (dst) { u32x2 o; o.x = pk2(o0, o1); o.y = pk2(o2, o3); *(u32x2*)(dst + (row0 + r) * DM + j * 256 + lane * 4) = o; }
      else { f32x4 o = {o0, o1, o2, o3}; *(f32x4*)(dstf + (row0 + r) * DM + j * 256 + lane * 4) = o; }
    }
  }
}
DEVI void conv_tile(const float* __restrict__ src, long ld, int col0, int nvalid, const float* __restrict__ kscale, bf16_t* dst, long ldd,
                    int n0, int k0, char* smem) {
  float* t = (float*)smem;
  const int tid = TID();
  __syncthreads();
  {
    const int c = tid & 31, r0 = tid >> 5;
#pragma unroll
    for (int i = 0; i < 8; ++i) {
      const int k = r0 + 8 * i; float v = 0.f;
      if (c < nvalid) { v = src[(long)(k0 + k) * ld + col0 + c]; if (kscale) v *= kscale[k0 + k]; }
      t[k * 33 + c] = v;
    }
  }
  __syncthreads();
  {
    const int n = tid >> 3, kc = (tid & 7) * 8;
    u32x4 o;
    o.x = pk2(t[(kc + 0) * 33 + n], t[(kc + 1) * 33 + n]); o.y = pk2(t[(kc + 2) * 33 + n], t[(kc + 3) * 33 + n]);
    o.z = pk2(t[(kc + 4) * 33 + n], t[(kc + 5) * 33 + n]); o.w = pk2(t[(kc + 6) * 33 + n], t[(kc + 7) * 33 + n]);
    *(u32x4*)(dst + (long)(n0 + n) * ldd + k0 + kc) = o;
  }
}

DEVI void phase_norm_conv(const Params& p, int l, int which, char* smem, bool rev) {
  const float* hsrc = (l == 0 && which == 0) ? p.x : p.out;
  const float* g = p.norm_g + (l * 3 + which) * DM;
  bf16_t* xn = (bf16_t*)(p.ws + OFF_XN);
  char* W = p.ws + OFF_W;
  const int nnorm = MTOK / 16;
  int nconv;
  if (which != 1) nconv = 2816 + 1408; else nconv = 2048 + 2048 + 1024 + 512 + 96 + 64 + 256 + 16 + 64 + 1;
  const int total = nnorm + nconv;
  for (int it = logical_block(); it < total; it += gridDim.x) {
    if (it < nnorm) { norm_rows(hsrc, g, xn, nullptr, rev ? nnorm - 1 - it : it); continue; }
    int c = it - nnorm;
    if (which != 1) {
      const int fi = l * 2 + (which == 2 ? 1 : 0);
      if (c < 2816) {
        const int nb = c >> 4, kt = c & 15, j = nb >> 1, part = nb & 1;
        const float* src = (part ? p.ffn_w_up : p.ffn_w_gate) + (size_t)fi * DM * DFF;
        conv_tile(src, DFF, 32 * j, 32, nullptr, (bf16_t*)(W + W_GU), DM, nb * 32, kt * 64, smem);
      } else {
        c -= 2816; const int nb = c / 44, kt = c % 44;
        conv_tile(p.ffn_w_down + (size_t)fi * DFF * DM, DM, nb * 32, 32, nullptr, (bf16_t*)(W + W_D), DFF, nb * 32, kt * 64, smem);
      }
      continue;
    }
    if (c < 2048) { const int nb = c >> 4, kt = c & 15; const Seg& sg = c_segs[find_seg(nb)];
      const int nv = (sg.mode == 3) ? 0 : (nb == 13 ? 24 : 32);
      conv_tile(p.w_in + (size_t)l * DM * 4024, 4024, sg.src_col + 32 * (nb - sg.blk0), nv, nullptr, (bf16_t*)(W + W_IN), DM, nb * 32, kt * 64, smem); continue; }
    c -= 2048;
    if (c < 2048) { const int i = c >> 9, r = c & 511, nb = r >> 4, kt = r & 15;
      conv_tile(p.w_gate + ((size_t)l * 4 + i) * DM * DM, DM, nb * 32, 32, nullptr, (bf16_t*)(W + W_G) + (size_t)i * DM * DM, DM, nb * 32, kt * 64, smem); continue; }
    c -= 2048;
    if (c < 1024) { const int i = c >> 8, r = c & 255, nb = r >> 3, kt = r & 7;
      conv_tile(p.w_branch + ((size_t)l * 4 + i) * 512 * DM, DM, nb * 32, 32, nullptr, (bf16_t*)(W + W_B) + (size_t)i * DM * 512, 512, nb * 32, kt * 64, smem); continue; }
    c -= 1024;
    if (c < 512) { const int nb = c >> 4, kt = c & 15;
      conv_tile(p.w_o + (size_t)l * DM * DM, DM, nb * 32, 32, nullptr, (bf16_t*)(W + W_O), DM, nb * 32, kt * 64, smem); continue; }
    c -= 512;
    if (c < 96) { const int nb = c >> 2, kt = c & 3;
      conv_tile(p.mla_w_uq + (size_t)l * 256 * 768, 768, nb * 32, 32, p.mla_q_norm + l * 256, (bf16_t*)(W + W_UQ), 256, nb * 32, kt * 64, smem); continue; }
    c -= 96;
    if (c < 64) { const int nb = c >> 1, kt = c & 1;
      conv_tile(p.mla_w_ukv + (size_t)l * 128 * 1024, 1024, nb * 32, 32, p.mla_kv_norm + l * 128, (bf16_t*)(W + W_UKV), 128, nb * 32, kt * 64, smem); continue; }
    c -= 64;
    if (c < 256) { const int kv = c >> 7, r = c & 127, nb = r >> 5, kt = r & 31;
      conv_tile(p.cmp_w1 + ((size_t)l * 2 + kv) * 2048 * 128, 128, nb * 32, 32, nullptr, (bf16_t*)(W + W_C1) + (size_t)kv * 128 * 2048, 2048, nb * 32, kt * 64, smem); continue; }
    c -= 256;
    if (c < 16) { const int kv = c >> 3, r = c & 7, nb = r >> 1, kt = r & 1;
      conv_tile(p.cmp_w2 + ((size_t)l * 2 + kv) * 128 * 64, 64, (nb & 1) * 32, nb < 2 ? 32 : 0, nullptr, (bf16_t*)(W + W_C2) + (size_t)kv * 128 * 128, 128, nb * 32, kt * 64, smem); continue; }
    c -= 16;
    if (c < 64) {
      const int kv = c >> 5, ch = c & 31, tid = TID(), j = tid & 127, hf = tid >> 7;
      const float* pos = p.cmp_pos + ((size_t)l * 2 + kv) * 2048; const float* w1 = p.cmp_w1 + ((size_t)l * 2 + kv) * 2048 * 128;
      float s = 0.f;
      const int k0 = ch * 64 + hf * 32;
#pragma unroll 8
      for (int k = k0; k < k0 + 32; ++k) s += pos[k] * w1[(size_t)k * 128 + j];
      float* t = (float*)smem;
      __syncthreads(); if (hf) t[j] = s; __syncthreads();
      if (!hf) ((float*)(p.ws + OFF_MISC + MISC_CBIAS))[(kv * 32 + ch) * 128 + j] = s + t[j];
      continue;
    }
    c -= 64;
    {
      float* lut = (float*)(p.ws + OFF_MISC + MISC_LUT);
      for (int idx = TID(); idx < 20 * 129; idx += 256) {
        const int hd = idx / 129, d = idx % 129; int bk;
        if (d < 16) bk = d; else { bk = 16 + (int)(logf((float)d / 16.f) / logf(8.f) * 16.f); if (bk > 31) bk = 31; }
        lut[hd * 132 + d] = p.rel_bias[bk * 20 + hd] * LOG2E;
      }
    }
  }
}

DEVI void phase_ffn_up(const Params& p, char* smem, bool rev) {
  const bf16_t* xn = (const bf16_t*)(p.ws + OFF_XN);
  const bf16_t* wgu = (const bf16_t*)(p.ws + OFF_W + W_GU);
  bf16_t* act = (bf16_t*)(p.ws + OFF_BIG + B_ACT);
  const int NT = 44, ntiles = 128 * NT, lb = logical_block(), G = gridDim.x;
  const int nseg = lb < ntiles ? (ntiles - lb + G - 1) / G : 0;
  auto segfn = [&](int j) { int mt, nt; tile_mn(lb + j * G, NT, mt, nt, rev); GSeg2 g; g.A = xn + (size_t)mt * 256 * DM; g.lda = DM; g.Bt = wgu + (size_t)nt * 128 * DM; g.ldb = DM; g.nk2 = 16; g.swp = true; return g; };
  auto epi = [&](int j, f32x16 (&acc)[4][2]) {
    int mt, nt; tile_mn(lb + j * G, NT, mt, nt, rev);
    const int t2 = TID(), lane = t2 & 63, w = t2 >> 6, wm = w >> 1, wn = w & 1;
    const int f0 = (nt * 128 + wn * 64) / 2 + 4 * (lane >> 5);
#pragma unroll
    for (int mi = 0; mi < 4; ++mi) {
      bf16_t* rp = act + ((long)mt * 256 + wm * 128 + mi * 32 + (lane & 31)) * DFF + f0;
#pragma unroll
      for (int t = 0; t < 4; ++t) {
        float o[4];
#pragma unroll
        for (int e = 0; e < 4; ++e) { const float g = acc[mi][0][4 * t + e], u = acc[mi][1][4 * t + e]; o[e] = g * sigm(g) * u; }
        u32x2 v; v.x = pk2(o[0], o[1]); v.y = pk2(o[2], o[3]); *(u32x2*)(rp + 8 * t) = v;
      }
    }
  };
  gemm_stream2(nseg, segfn, epi, smem);
}
DEVI void gemm_resid_phase(const bf16_t* A, int lda, int nk, const bf16_t* Bt, const float* res, float* out, float alpha, char* smem, bool rev) {
  const int NT = 8, ntiles = 128 * NT, lb = logical_block(), G = gridDim.x;
  const int nseg = lb < ntiles ? (ntiles - lb + G - 1) / G : 0;
  auto segfn = [&](int j) { int mt, nt; tile_mn(lb + j * G, NT, mt, nt, rev); GSeg2 g; g.A = A + (size_t)mt * 256 * lda; g.lda = lda; g.Bt = Bt + (size_t)nt * 128 * lda; g.ldb = lda; g.nk2 = nk; g.swp = true; return g; };
  auto epi = [&](int j, f32x16 (&acc)[4][2]) {
    int mt, nt; tile_mn(lb + j * G, NT, mt, nt, rev);
    const int t2 = TID(), lane = t2 & 63, w = t2 >> 6, wm = w >> 1, wn = w & 1;
#pragma unroll
    for (int mi = 0; mi < 4; ++mi)
#pragma unroll
      for (int ni = 0; ni < 2; ++ni) {
        const long idx0 = ((long)mt * 256 + wm * 128 + mi * 32 + (lane & 31)) * DM + nt * 128 + wn * 64 + ni * 32 + 4 * (lane >> 5);
#pragma unroll
        for (int t = 0; t < 4; ++t) {
          const f32x4 r = *(const f32x4*)(res + idx0 + 8 * t);
          f32x4 o = {r[0] + alpha * acc[mi][ni][4 * t], r[1] + alpha * acc[mi][ni][4 * t + 1], r[2] + alpha * acc[mi][ni][4 * t + 2], r[3] + alpha * acc[mi][ni][4 * t + 3]};
          *(f32x4*)(out + idx0 + 8 * t) = o;
        }
      }
  };
  gemm_stream2(nseg, segfn, epi, smem);
}

DEVI void phase_win(const Params& p, char* smem, bool rev) {
  const bf16_t* u = (const bf16_t*)(p.ws + OFF_XN);
  const bf16_t* win = (const bf16_t*)(p.ws + OFF_W + W_IN);
  char* big = p.ws + OFF_BIG;
  const int NT = 32, ntiles = 128 * NT, lb = logical_block(), G = gridDim.x;
  const int nseg = lb < ntiles ? (ntiles - lb + G - 1) / G : 0;
  auto segfn = [&](int j) { int mt, nt; tile_mn(lb + j * G, NT, mt, nt, rev); GSeg2 g; g.A = u + (size_t)mt * 256 * DM; g.lda = DM; g.Bt = win + (size_t)nt * 128 * DM; g.ldb = DM; g.nk2 = 16; g.swp = true; return g; };
  auto epi = [&](int j, f32x16 (&acc)[4][2]) {
    int mt, nt; tile_mn(lb + j * G, NT, mt, nt, rev);
    const int t2 = TID(), lane = t2 & 63, w = t2 >> 6, wm = w >> 1, wn = w & 1;
    const long tok0 = (long)mt * 256 + wm * 128;
#pragma unroll
    for (int ni = 0; ni < 2; ++ni) {
      const int blk = nt * 4 + wn * 2 + ni;
      const Seg sg = c_segs[find_seg(blk)];
      bf16_t* base = (bf16_t*)(big + ((size_t)sg.off_kib << 10));
      const int cb = 32 * (blk - sg.blk0);
      if (sg.mode == 0) {
#pragma unroll
        for (int mi = 0; mi < 4; ++mi) st_rm_s(base + cb, sg.ld, tok0 + mi * 32, acc[mi][ni], lane);
      } else if (sg.mode == 1) {
        const int b = (int)(tok0 >> 13), sq = (int)(tok0 & (SEQ - 1));
#pragma unroll
        for (int mi = 0; mi < 4; ++mi) st_tr_s(base + ((size_t)b * sg.ld + cb) * SEQ, SEQ, sq + mi * 32, acc[mi][ni], lane);
      } else if (sg.mode == 2) {
#pragma unroll
        for (int mi = 0; mi < 4; ++mi) { f32x16 r = rope_blk_s(acc[mi][ni], (int)((tok0 + mi * 32) & (SEQ - 1)), lane); st_rm_s(base + cb, sg.ld, tok0 + mi * 32, r, lane); }
      }
    }
  };
  gemm_stream2(nseg, segfn, epi, smem);
}

template <int DK, int DV, int MODE>
DEVI void flash_loop(f32x16 (&o)[DV / 32], float& m_, float& l_, const bf16x8 (&qf)[DK / 16], const bf16_t* __restrict__ kA, long ldkA,
                     const bf16_t* __restrict__ kB, long ldkB, const bf16_t* __restrict__ vt, long ldv, int kt0, int kt1, int q, int qa,
                     int W, const float* lut, float bias_far, float sc, u32x4 selm, char* smem) {
  constexpr int KS = DK + 8, VS = 68, KCH = DK / 8, NKC = KCH * 64 / 256, NVC = DV * 8 / 256;
  const int tid = TID(), lane = tid & 63, h = lane >> 5;
  bf16_t* sK = (bf16_t*)smem;
  bf16_t* sV = sK + 2 * 64 * KS;
  u32x4 rk[NKC], rv[NVC];
  auto gload = [&](int kt) {
#pragma unroll
    for (int i = 0; i < NKC; ++i) {
      const int c = tid + 256 * i, r = c / KCH, kc = c % KCH; const long key = (long)kt * 64 + r;
      if (DK == 64 || kc < 8) rk[i] = *(const u32x4*)(kA + key * ldkA + kc * 8);
      else rk[i] = *(const u32x4*)(kB + key * ldkB + (kc - 8) * 8);
    }
#pragma unroll
    for (int i = 0; i < NVC; ++i) { const int c = tid + 256 * i, r = c >> 3, kc = c & 7; rv[i] = *(const u32x4*)(vt + (long)r * ldv + (long)kt * 64 + kc * 8); }
  };
  auto swrite = [&](int buf) {
#pragma unroll
    for (int i = 0; i < NKC; ++i) { const int c = tid + 256 * i, r = c / KCH, kc = c % KCH; *(u32x4*)(sK + buf * 64 * KS + r * KS + kc * 8) = rk[i]; }
#pragma unroll
    for (int i = 0; i < NVC; ++i) {
      const int c = tid + 256 * i, r = c >> 3, kc = c & 7; bf16_t* d = sV + buf * DV * VS + r * VS + kc * 8;
      u32x2 lo = {rv[i][0], rv[i][1]}, hi = {rv[i][2], rv[i][3]}; *(u32x2*)d = lo; *(u32x2*)(d + 4) = hi;
    }
  };
  __syncthreads();
  if (kt0 < kt1) { gload(kt0); swrite(0); }
  __syncthreads();
  for (int kt = kt0; kt < kt1; ++kt) {
    const int buf = (kt - kt0) & 1;
    if (kt + 1 < kt1) gload(kt + 1);
    const int kb = kt * 64;
    bool skip, fast; bool lane_ok = true;
    if (MODE == 0) { skip = kb > qa + 31; fast = kb + 63 <= qa; }
    else if (MODE == 1) { skip = (kb > qa + 31) || (kb + 63 < qa - (W - 1)); fast = (kb + 63 <= qa) && (qa + 31 - kb < W) && (qa - (kb + 63) >= 128); }
    else if (MODE == 2) { skip = 16 * kb > qa; fast = 16 * (kb + 63) + 31 <= qa; }
    else {
      const unsigned wsel = (kt < 32) ? selm[0] : (kt < 64) ? selm[1] : (kt < 96) ? selm[2] : selm[3];
      lane_ok = (wsel >> (kt & 31)) & 1u;
      skip = (kb > qa + 31) || (__ballot(lane_ok) == 0ull); fast = (qa - (kb + 63) >= 128);
    }
    if (!skip) {
      f32x16 s[2]; s[0] = zero16(); s[1] = zero16();
      const bf16_t* kp = sK + buf * 64 * KS + (lane & 31) * KS + h * 8;
      if (MODE == 2) {
#pragma unroll
        for (int ks = 0; ks < DK / 16; ++ks) {
          const bf16x8 a0 = *(const bf16x8*)(kp + ks * 16), a1 = *(const bf16x8*)(kp + 32 * KS + ks * 16);
          s[0] = mfma32(a0, qf[ks], s[0]); s[1] = mfma32(a1, qf[ks], s[1]);
        }
      } else {
        constexpr int KG = DK / 16;
#pragma unroll
        for (int g0 = 0; g0 < DK / 16; g0 += KG) {
          bf16x8 kf0[KG], kf1[KG];
#pragma unroll
          for (int ks = 0; ks < KG; ++ks) { kf0[ks] = *(const bf16x8*)(kp + (g0 + ks) * 16); kf1[ks] = *(const bf16x8*)(kp + 32 * KS + (g0 + ks) * 16); }
          __builtin_amdgcn_sched_barrier(0);
#pragma unroll
          for (int ks = 0; ks < KG; ++ks) { s[0] = mfma32(kf0[ks], qf[g0 + ks], s[0]); s[1] = mfma32(kf1[ks], qf[g0 + ks], s[1]); }
        }
      }
      constexpr int VPRE = (MODE == 2) ? 0 : (MODE == 0) ? 2 : 1;
      const bf16_t* vp = sV + buf * DV * VS + (lane & 31) * VS + h * 4;
      u32x4 vf[VPRE + 1][4];
#pragma unroll
      for (int dvb = 0; dvb < VPRE; ++dvb)
#pragma unroll
        for (int kk = 0; kk < 4; ++kk) {
          const u32x2 lo = *(const u32x2*)(vp + dvb * 32 * VS + kk * 16), hi = *(const u32x2*)(vp + dvb * 32 * VS + kk * 16 + 8);
          vf[dvb][kk] = (u32x4){lo.x, lo.y, hi.x, hi.y};
        }
      __builtin_amdgcn_sched_barrier(0);
      float mx = -__builtin_huge_valf();
      const float cb = (MODE == 1 || MODE == 3) ? bias_far : 0.f;
      if (fast) {
#pragma unroll
        for (int b2 = 0; b2 < 2; ++b2)
#pragma unroll
          for (int reg = 0; reg < 16; ++reg) mx = fmaxf(mx, s[b2][reg]);
        mx = __builtin_fmaf(mx, sc, cb);
        if (MODE == 3) mx = lane_ok ? mx : -__builtin_huge_valf();
      } else {
#pragma unroll
        for (int b2 = 0; b2 < 2; ++b2)
#pragma unroll
          for (int reg = 0; reg < 16; ++reg) {
            const int key = kb + b2 * 32 + rowoff(reg, h);
            bool ok; float t;
            if (MODE == 2) { ok = 16 * key + 31 <= q; t = s[b2][reg] * sc; }
            else {
              const int d = q - key; ok = d >= 0;
              if (MODE == 1) ok = ok && (d < W);
              if (MODE == 3) ok = ok && lane_ok;
              float bias = 0.f;
              if (MODE == 1 || MODE == 3) { int di = d < 0 ? 0 : (d > 128 ? 128 : d); bias = lut[di]; }
              t = __builtin_fmaf(s[b2][reg], sc, bias);
            }
            t = ok ? t : -__builtin_huge_valf();
            s[b2][reg] = t; mx = fmaxf(mx, t);
          }
      }
      mx = fmaxf(mx, __shfl_xor(mx, 32));
      if (__ballot(mx - m_ > 8.f) != 0ull) {
        const float mnew = fmaxf(m_, mx);
        const float mu = (mnew == -__builtin_huge_valf()) ? 0.f : mnew;
        const float alpha = fexp2(m_ - mu);
        m_ = mnew; l_ *= alpha;
#pragma unroll
        for (int dvb = 0; dvb < DV / 32; ++dvb)
#pragma unroll
          for (int reg = 0; reg < 16; ++reg) o[dvb][reg] *= alpha;
      }
      const float muse = (m_ == -__builtin_huge_valf()) ? 0.f : m_;
      float ls = 0.f;
      if (fast) {
        const float off = cb - muse;
#pragma unroll
        for (int b2 = 0; b2 < 2; ++b2)
#pragma unroll
          for (int reg = 0; reg < 16; ++reg) {
            float pz = fexp2(__builtin_fmaf(s[b2][reg], sc, off));
            if (MODE == 3) pz = lane_ok ? pz : 0.f;
            s[b2][reg] = pz; ls += pz;
          }
      } else {
#pragma unroll
        for (int b2 = 0; b2 < 2; ++b2)
#pragma unroll
          for (int reg = 0; reg < 16; ++reg) { const float pz = fexp2(s[b2][reg] - muse); s[b2][reg] = pz; ls += pz; }
      }
      l_ += ls;
      bf16x8 pb[4];
#pragma unroll
      for (int kk = 0; kk < 4; ++kk) {
        const int b2 = kk >> 1, s8 = (kk & 1) * 8;
        u32x4 pv; pv.x = pk2(s[b2][s8 + 0], s[b2][s8 + 1]); pv.y = pk2(s[b2][s8 + 2], s[b2][s8 + 3]);
        pv.z = pk2(s[b2][s8 + 4], s[b2][s8 + 5]); pv.w = pk2(s[b2][s8 + 6], s[b2][s8 + 7]);
        pb[kk] = __builtin_bit_cast(bf16x8, pv);
      }
#pragma unroll
      for (int dvb = 0; dvb < VPRE; ++dvb)
#pragma unroll
        for (int kk = 0; kk < 4; ++kk) o[dvb] = mfma32(__builtin_bit_cast(bf16x8, vf[dvb][kk]), pb[kk], o[dvb]);
#pragma unroll
      for (int dvb = VPRE; dvb < DV / 32; ++dvb) {
        u32x4 vv[4];
#pragma unroll
        for (int kk = 0; kk < 4; ++kk) {
          const u32x2 lo = *(const u32x2*)(vp + dvb * 32 * VS + kk * 16), hi = *(const u32x2*)(vp + dvb * 32 * VS + kk * 16 + 8);
          vv[kk] = (u32x4){lo.x, lo.y, hi.x, hi.y};
        }
        __builtin_amdgcn_sched_barrier(0);
#pragma unroll
        for (int kk = 0; kk < 4; ++kk) o[dvb] = mfma32(__builtin_bit_cast(bf16x8, vv[kk]), pb[kk], o[dvb]);
      }
      if (kt + 1 < kt1) swrite(buf ^ 1);
    } else if (kt + 1 < kt1) swrite(buf ^ 1);
    __syncthreads();
  }
}

template <int NK>
DEVI void load_qf(bf16x8 (&qf)[NK], const bf16_t* qrow, int h, int ks0) {
#pragma unroll
  for (int ks = 0; ks < NK; ++ks) if (ks >= ks0) qf[ks] = *(const bf16x8*)(qrow + (ks - ks0) * 16 + 8 * h);
}
template <int NB>
DEVI void store_o(const f32x16 (&o)[NB], float scale, bf16_t* dst, int h) {
#pragma unroll
  for (int dvb = 0; dvb < NB; ++dvb)
#pragma unroll
    for (int t = 0; t < 4; ++t) {
      u32x2 v; v.x = pk2(o[dvb][4 * t] * scale, o[dvb][4 * t + 1] * scale); v.y = pk2(o[dvb][4 * t + 2] * scale, o[dvb][4 * t + 3] * scale);
      *(u32x2*)(dst + dvb * 32 + 8 * t + 4 * h) = v;
    }
}
DEVI void load_lut(const Params& p, int hd, char* smem, float*& lut, float& far_) {
  lut = (float*)(smem + 60000);
  const float* g = (const float*)(p.ws + OFF_MISC + MISC_LUT) + hd * 132;
  __syncthreads();
  if (TID() < 129) lut[TID()] = g[TID()];
  __syncthreads();
  far_ = g[128];
}

DEVI void item_swa(const Params& p, int l, int b, int head, int qb, char* smem) {
  const int hkv = head >> 2;
  const int lane = TID() & 63, w = TID() >> 6, h = lane >> 5;
  char* big = p.ws + OFF_BIG;
  const int q0 = qb * 128, qa = q0 + 32 * w, q = qa + (lane & 31);
  float* lut; float far_; load_lut(p, head, smem, lut, far_);
  bf16_t* qrow = (bf16_t*)(big + B_SQ) + ((size_t)b * SEQ + q) * 512 + head * 64;
  bf16x8 qf[4]; load_qf<4>(qf, qrow, h, 0);
  f32x16 o[2]; o[0] = zero16(); o[1] = zero16();
  float m_ = p.swa_sinks[l * 8 + head] * LOG2E, l_ = h ? 0.f : 1.f;
  const bf16_t* kA = (const bf16_t*)(big + B_SK) + (size_t)b * SEQ * 128 + hkv * 64;
  const bf16_t* vt = (const bf16_t*)(big + B_SVT) + ((size_t)b * 128 + hkv * 64) * SEQ;
  int kt0 = q0 / 64 - 2; if (kt0 < 0) kt0 = 0;
  u32x4 sm = {0, 0, 0, 0};
  flash_loop<64, 64, 1>(o, m_, l_, qf, kA, 128, nullptr, 0, vt, SEQ, kt0, q0 / 64 + 2, q, qa, 128, lut, far_, 0.125f * LOG2E, sm, smem);
  const float lt = l_ + __shfl_xor(l_, 32);
  store_o<2>(o, frcp(lt), qrow, h);
}

DEVI void item_mla(const Params& p, int b, int head, int qb, char* smem) {
  const int lane = TID() & 63, w = TID() >> 6, h = lane >> 5;
  char* big = p.ws + OFF_BIG;
  const int q0 = qb * 128, qa = q0 + 32 * w, q = qa + (lane & 31);
  bf16_t* qrow = (bf16_t*)(big + B_QN) + ((size_t)b * SEQ + q) * 512 + head * 64;
  const bf16_t* qrr = (const bf16_t*)(big + B_QR) + ((size_t)b * SEQ + q) * 256 + head * 32;
  bf16x8 qf[6];
#pragma unroll
  for (int ks = 0; ks < 4; ++ks) qf[ks] = *(const bf16x8*)(qrow + ks * 16 + 8 * h);
#pragma unroll
  for (int ks = 0; ks < 2; ++ks) qf[4 + ks] = *(const bf16x8*)(qrr + ks * 16 + 8 * h);
  f32x16 o[2]; o[0] = zero16(); o[1] = zero16();
  float m_ = -__builtin_huge_valf(), l_ = 0.f;
  const bf16_t* kA = (const bf16_t*)(big + B_KN) + (size_t)b * SEQ * 512 + head * 64;
  const bf16_t* kB = (const bf16_t*)(big + B_KROPE) + (size_t)b * SEQ * 32;
  const bf16_t* vt = (const bf16_t*)(big + B_MVT) + ((size_t)b * 512 + head * 64) * SEQ;
  u32x4 sm = {0, 0, 0, 0};
  flash_loop<96, 64, 0>(o, m_, l_, qf, kA, 512, kB, 32, vt, SEQ, 0, q0 / 64 + 2, q, qa, 0, nullptr, 0.f, 0.10206207261596575f * LOG2E, sm, smem);
  const float lt = l_ + __shfl_xor(l_, 32);
  store_o<2>(o, frcp(lt), qrow, h);
}

DEVI void item_diff(const Params& p, int l, int b, int hd, int qb, char* smem) {
  char* big = p.ws + OFF_BIG;
  const int q0 = qb * 128;
  float* lut; float far_; load_lut(p, 16 + hd, smem, lut, far_);
  const bf16_t* kA = (const bf16_t*)(big + B_DK) + (size_t)b * SEQ * 512 + hd * 128;
  const bf16_t* vt = (const bf16_t*)(big + B_DVT) + ((size_t)b * 512 + hd * 128) * SEQ;
  const u32x4 sm = {0, 0, 0, 0};
  f32x16 o[4];
#pragma unroll 1
  for (int pass = 0; pass < 2; ++pass) {
#pragma unroll
    for (int i = 0; i < 4; ++i) o[i] = zero16();
    float m_ = -__builtin_huge_valf(), l_ = 0.f;
    {
      const int t = TID(), lane = t & 63, w = t >> 6, h = lane >> 5, qa = q0 + 32 * w, q = qa + (lane & 31);
      const bf16_t* qrow = (const bf16_t*)(big + B_DQ) + ((size_t)b * SEQ + q) * 512 + hd * 128 + pass * 64;
      bf16x8 qf[4]; load_qf<4>(qf, qrow, h, 0);
      flash_loop<64, 128, 1>(o, m_, l_, qf, kA + pass * 64, 512, nullptr, 0, vt, SEQ, 0, q0 / 64 + 2, q, qa, 1 << 30, lut, far_, 0.125f * LOG2E, sm, smem);
    }
    if (pass == 0) {
      const float il = frcp(l_ + __shfl_xor(l_, 32));
      unsigned* scr = (unsigned*)(p.ws + OFF_SCR) + (size_t)blockIdx.x * 8192 + TID();
#pragma unroll
      for (int i = 0; i < 4; ++i)
#pragma unroll
        for (int r = 0; r < 8; ++r) scr[(i * 8 + r) * 256] = pk2(o[i][2 * r] * il, o[i][2 * r + 1] * il);
    } else {
      const int t = TID(), lane = t & 63, w = t >> 6, h = lane >> 5, q = q0 + 32 * w + (lane & 31);
      const float lam_init = 0.8f - 0.6f * __expf(-0.3f * (float)l);
      float lam;
      { const float* lp = p.diff_lambda + l * 256; float a = wave_sum(lp[lane] * lp[64 + lane]), c = wave_sum(lp[128 + lane] * lp[192 + lane]); lam = __expf(a) - __expf(c) + lam_init; }
      const float il = frcp(l_ + __shfl_xor(l_, 32)) * lam;
      const unsigned* scr = (const unsigned*)(p.ws + OFF_SCR) + (size_t)blockIdx.x * 8192 + t;
      float ss = 0.f;
#pragma unroll
      for (int i = 0; i < 4; ++i)
#pragma unroll
        for (int r = 0; r < 8; ++r) {
          const unsigned sv = scr[(i * 8 + r) * 256];
          const float a0 = __uint_as_float(sv << 16), a1 = __uint_as_float(sv & 0xffff0000u);
          const float v0 = a0 - o[i][2 * r] * il, v1 = a1 - o[i][2 * r + 1] * il;
          o[i][2 * r] = v0; o[i][2 * r + 1] = v1; ss += v0 * v0 + v1 * v1;
        }
      ss += __shfl_xor(ss, 32);
      const float rstd = rsqrtf(ss * (1.f / 128.f) + 1e-6f) * (1.f - lam_init);
      const float* sub = p.diff_subln + l * 128;
      bf16_t* qrow = (bf16_t*)(big + B_DQ) + ((size_t)b * SEQ + q) * 512 + hd * 128;
#pragma unroll
      for (int i = 0; i < 4; ++i)
#pragma unroll
        for (int tq = 0; tq < 4; ++tq) {
          const int dv = i * 32 + 8 * tq + 4 * h;
          const f32x4 gv = *(const f32x4*)(sub + dv);
          u32x2 v; v.x = pk2(o[i][4 * tq] * rstd * gv[0], o[i][4 * tq + 1] * rstd * gv[1]); v.y = pk2(o[i][4 * tq + 2] * rstd * gv[2], o[i][4 * tq + 3] * rstd * gv[3]);
          *(u32x2*)(qrow + dv) = v;
        }
    }
  }
}

DEVI void item_cmp(const Params& p, int bh, int qb, char* smem) {
  const int b = bh >> 1, hkv = bh & 1;
  const int tid = TID(), lane = tid & 63, w = tid >> 6, h = lane >> 5, c = lane & 31;
  char* big = p.ws + OFF_BIG;
  const int q0 = qb * 128, qa = q0 + 32 * w, q = qa + c;
  const bf16_t* kA = (const bf16_t*)(big + B_KCMP) + (size_t)bh * 512 * 64;
  const bf16_t* vt = (const bf16_t*)(big + B_VCMPT) + (size_t)bh * 64 * 512;
  int ntiles = ((q0 + 127 - 31) >> 4) / 64 + 1; if (ntiles > 8) ntiles = 8;
  const float sc = 0.125f * LOG2E;
  const size_t tok = (size_t)b * SEQ + q;
  const bf16_t* qbase = (const bf16_t*)(big + B_NQ) + tok * 512 + hkv * 256;
  const bf16_t* gate = (const bf16_t*)(big + B_NGATE) + tok * 32 + hkv * 12;
  float mg[4], ilg[4];
  u32x4 sm = {0, 0, 0, 0};
#pragma unroll
  for (int g = 0; g < 4; ++g) {
    bf16x8 qf[4]; load_qf<4>(qf, qbase + g * 64, h, 0);
    f32x16 o[2]; o[0] = zero16(); o[1] = zero16();
    float m_ = -__builtin_huge_valf(), l_ = 0.f;
    flash_loop<64, 64, 2>(o, m_, l_, qf, kA, 64, nullptr, 0, vt, 512, 0, ntiles, q, qa, 0, nullptr, 0.f, sc, sm, smem);
    const float lt = l_ + __shfl_xor(l_, 32);
    const float il = lt > 0.f ? frcp(lt) : 0.f;
    mg[g] = m_; ilg[g] = il;
    const float g0 = sigm(bf2f(gate[g * 3 + 0]));
    store_o<2>(o, il * g0, (bf16_t*)(big + B_OC) + tok * 512 + (hkv * 4 + g) * 64, h);
  }
  bf16_t* sK = (bf16_t*)smem;
  float* imp = (float*)(smem + 9216);
  float carry = 0.f;
  const int cur = q >> 6;
  for (int kt = 0; kt < 8; ++kt) {
    __syncthreads();
    if (kt < ntiles) {
#pragma unroll
      for (int i = 0; i < 2; ++i) { const int ch = tid + 256 * i, r = ch >> 3, kc = ch & 7; *(u32x4*)(sK + r * 72 + kc * 8) = *(const u32x4*)(kA + ((size_t)kt * 64 + r) * 64 + kc * 8); }
    }
    __syncthreads();
    f32x16 ps[2]; ps[0] = zero16(); ps[1] = zero16();
    const int kb = kt * 64;
    if (kt < ntiles && 16 * kb <= qa) {
      const bf16_t* kp = sK + c * 72 + h * 8;
#pragma unroll
      for (int g = 0; g < 4; ++g) {
        f32x16 s[2]; s[0] = zero16(); s[1] = zero16();
        bf16x8 qf[4]; load_qf<4>(qf, qbase + g * 64, h, 0);
#pragma unroll
        for (int ks = 0; ks < 4; ++ks) {
          const bf16x8 a0 = *(const bf16x8*)(kp + ks * 16), a1 = *(const bf16x8*)(kp + 32 * 72 + ks * 16);
          s[0] = mfma32(a0, qf[ks], s[0]); s[1] = mfma32(a1, qf[ks], s[1]);
        }
#pragma unroll
        for (int b2 = 0; b2 < 2; ++b2)
#pragma unroll
          for (int reg = 0; reg < 16; ++reg) {
            const int key = kb + b2 * 32 + rowoff(reg, h);
            const bool ok = 16 * key + 31 <= q;
            const float pz = fexp2(s[b2][reg] * sc - mg[g]) * ilg[g];
            ps[b2][reg] += ok ? pz : 0.f;
          }
      }
    }
    float ol[2][4];
#pragma unroll
    for (int b2 = 0; b2 < 2; ++b2)
#pragma unroll
      for (int t = 0; t < 4; ++t) ol[b2][t] = __shfl_xor(ps[b2][4 * t + 3], 32);
#pragma unroll
    for (int b2 = 0; b2 < 2; ++b2)
#pragma unroll
      for (int t = 0; t < 4; ++t) {
        const float qs = ps[b2][4 * t] + ps[b2][4 * t + 1] + ps[b2][4 * t + 2] + ps[b2][4 * t + 3];
        const float prev = h ? ol[b2][t] : (t > 0 ? ol[b2][t - 1] : (b2 > 0 ? ol[0][3] : carry));
        const int n = kt * 16 + 8 * b2 + 2 * t + h;
        float val = qs + prev;
        const bool causal = 64 * n <= q, forced = (n == 0) || (n == cur) || (n == cur - 1);
        val = causal ? (forced ? 1e4f : val) : -1.f;
        imp[(32 * w + c) * 132 + n] = val;
      }
    carry = ol[1][3];
  }
  __syncthreads();
  {
    const int t = TID(), ql = t >> 1, hf = t & 1;
    const float* row = imp + ql * 132 + hf * 64;
    unsigned key[64];
#pragma unroll
    for (int i4 = 0; i4 < 16; ++i4) {
      const f32x4 x = *(const f32x4*)(row + 4 * i4);
#pragma unroll
      for (int e = 0; e < 4; ++e) { const unsigned u = __float_as_uint(x[e]); key[4 * i4 + e] = (u & 0x80000000u) ? ~u : (u | 0x80000000u); }
    }
    unsigned T = 0;
#pragma unroll 1
    for (int bit = 31; bit >= 0; --bit) {
      const unsigned cand = T | (1u << bit);
      int cnt = 0;
#pragma unroll
      for (int i = 0; i < 64; ++i) cnt += (key[i] >= cand) ? 1 : 0;
      cnt += __shfl_xor(cnt, 1);
      if (cnt >= 16) T = cand;
    }
    int cgt = 0, eq = 0;
#pragma unroll
    for (int i = 0; i < 64; ++i) { cgt += (key[i] > T) ? 1 : 0; eq += (key[i] == T) ? 1 : 0; }
    const int cgt_o = __shfl_xor(cgt, 1), eq_o = __shfl_xor(eq, 1);
    int r = 16 - (cgt + cgt_o);
    if (hf) r -= eq_o;
    unsigned m0 = 0, m1 = 0;
#pragma unroll
    for (int i = 0; i < 64; ++i) {
      bool sel = key[i] > T;
      if (key[i] == T) { sel = r > 0; --r; }
      if (i < 32) m0 |= sel ? (1u << i) : 0u; else m1 |= sel ? (1u << (i - 32)) : 0u;
    }
    unsigned* selm = (unsigned*)(big + B_SELM) + ((size_t)bh * SEQ + q0 + ql) * 4 + hf * 2;
    u32x2 mv = {m0, m1}; *(u32x2*)selm = mv;
  }
}

DEVI void item_selwin(const Params& p, int b, int head, int qb, char* smem) {
  const int hkv = head >> 2;
  const int lane = TID() & 63, w = TID() >> 6, h = lane >> 5;
  char* big = p.ws + OFF_BIG;
  const int q0 = qb * 128, qa = q0 + 32 * w, q = qa + (lane & 31);
  const size_t tok = (size_t)b * SEQ + q;
  float* lut; float far_; load_lut(p, 8 + head, smem, lut, far_);
  bf16_t* qrow = (bf16_t*)(big + B_NQ) + tok * 512 + head * 64;
  bf16x8 qf[4]; load_qf<4>(qf, qrow, h, 0);
  const u32x4 sm = *(const u32x4*)((const unsigned*)(big + B_SELM) + ((size_t)(b * 2 + hkv) * SEQ + q) * 4);
  const bf16_t* gate = (const bf16_t*)(big + B_NGATE) + tok * 32 + head * 3;
  const float g1 = sigm(bf2f(gate[1])), g2 = sigm(bf2f(gate[2]));
  const float sc = 0.125f * LOG2E;
  f32x16 res[2];
  {
    f32x16 o[2]; o[0] = zero16(); o[1] = zero16();
    float m_ = -__builtin_huge_valf(), l_ = 0.f;
    const bf16_t* kA = (const bf16_t*)(big + B_NKS) + (size_t)b * SEQ * 128 + hkv * 64;
    const bf16_t* vt = (const bf16_t*)(big + B_NVST) + ((size_t)b * 128 + hkv * 64) * SEQ;
    flash_loop<64, 64, 3>(o, m_, l_, qf, kA, 128, nullptr, 0, vt, SEQ, 0, q0 / 64 + 2, q, qa, 1 << 30, lut, far_, sc, sm, smem);
    const float il = frcp(l_ + __shfl_xor(l_, 32)) * g1;
    res[0] = o[0] * il; res[1] = o[1] * il;
  }
  {
    f32x16 o[2]; o[0] = zero16(); o[1] = zero16();
    float m_ = -__builtin_huge_valf(), l_ = 0.f;
    const bf16_t* kA = (const bf16_t*)(big + B_NKW) + (size_t)b * SEQ * 128 + hkv * 64;
    const bf16_t* vt = (const bf16_t*)(big + B_NVWT) + ((size_t)b * 128 + hkv * 64) * SEQ;
    int kt0 = q0 / 64 - 8; if (kt0 < 0) kt0 = 0;
    flash_loop<64, 64, 1>(o, m_, l_, qf, kA, 128, nullptr, 0, vt, SEQ, kt0, q0 / 64 + 2, q, qa, 512, lut, far_, sc, sm, smem);
    const float il = frcp(l_ + __shfl_xor(l_, 32)) * g2;
    res[0] += o[0] * il; res[1] += o[1] * il;
  }
  const bf16_t* oc = (const bf16_t*)(big + B_OC) + tok * 512 + head * 64;
#pragma unroll
  for (int dvb = 0; dvb < 2; ++dvb)
#pragma unroll
    for (int t = 0; t < 4; ++t) {
      const int dv = dvb * 32 + 8 * t + 4 * h;
      const u32x2 ov = *(const u32x2*)(oc + dv);
      const float c0 = __uint_as_float(ov.x << 16), c1 = __uint_as_float(ov.x & 0xffff0000u), c2 = __uint_as_float(ov.y << 16), c3 = __uint_as_float(ov.y & 0xffff0000u);
      u32x2 v; v.x = pk2(res[dvb][4 * t] + c0, res[dvb][4 * t + 1] + c1); v.y = pk2(res[dvb][4 * t + 2] + c2, res[dvb][4 * t + 3] + c3);
      *(u32x2*)(qrow + dv) = v;
    }
}

DEVI void item_mla_expand(const Params& p, int kind, int i, char* smem) {
  char* big = p.ws + OFF_BIG;
  const int tid = TID(), lane = tid & 63, w = tid >> 6, wm = w >> 1, wn = w & 1;
  const int NT = kind ? 8 : 6, mt = i / NT, nt = i % NT, K = kind ? 128 : 256;
  const bf16_t* A = (const bf16_t*)(big + (kind ? B_CKV : B_CQ)) + (size_t)mt * 128 * K;
  const bf16_t* Bt = (const bf16_t*)(p.ws + OFF_W + (kind ? W_UKV : W_UQ)) + (size_t)nt * 128 * K;
  float* sR = (float*)(smem + 73728);
  __syncthreads();
  {
    const int r = tid >> 1, hf = tid & 1, n = K / 2; const bf16_t* rp = A + (size_t)r * K + hf * n; float ss = 0.f;
    for (int j = 0; j < n; j += 8) { const u32x4 v = *(const u32x4*)(rp + j);
#pragma unroll
      for (int e = 0; e < 4; ++e) { const float a = __uint_as_float(v[e] << 16), bq = __uint_as_float(v[e] & 0xffff0000u); ss += a * a + bq * bq; } }
    ss += __shfl_xor(ss, 1);
    if (!hf) sR[r] = rsqrtf(ss / (float)K + 1e-6f);
  }
  const bool swp = (kind == 0) || (wn == 0);
  f32x16 acc[2][2]; zero_acc(acc);
  gemm_core(acc, A, K, 64, Bt, K, K / 64, smem, swp);
#pragma unroll
  for (int mi = 0; mi < 2; ++mi) {
    const int lr0 = wm * 64 + mi * 32; const long row0 = (long)mt * 128 + lr0;
#pragma unroll
    for (int ni = 0; ni < 2; ++ni) {
      f32x16 a = acc[mi][ni];
      const int cb = nt * 4 + wn * 2 + ni;
      if (swp) {
        const float rs = sR[lr0 + (lane & 31)];
#pragma unroll
        for (int reg = 0; reg < 16; ++reg) a[reg] *= rs;
        if (kind == 0) {
          const int head = cb / 3, part = cb % 3;
          if (part < 2) st_rm_s((bf16_t*)(big + B_QN) + head * 64 + part * 32, 512, row0, a, lane);
          else { f32x16 r = rope_blk_s(a, (int)(row0 & (SEQ - 1)), lane); st_rm_s((bf16_t*)(big + B_QR) + head * 32, 256, row0, r, lane); }
        } else {
          const int head = cb >> 2, part = cb & 3;
          st_rm_s((bf16_t*)(big + B_KN) + head * 64 + part * 32, 512, row0, a, lane);
        }
      } else {
#pragma unroll
        for (int reg = 0; reg < 16; ++reg) a[reg] *= sR[lr0 + rowoff(reg, lane >> 5)];
        const int head = cb >> 2, part = cb & 3;
        const int b = (int)(row0 >> 13);
        st_tr((bf16_t*)(big + B_MVT) + ((size_t)b * 512 + head * 64 + (part - 2) * 32) * SEQ, SEQ, (int)(row0 & (SEQ - 1)), a, lane);
      }
    }
  }
}
DEVI float gelu_tanh(float x) {
  const float z = 0.7978845608028654f * (x + 0.044715f * x * x * x);
  const float th = 1.f - 2.f * frcp(1.f + fexp2(2.f * z * LOG2E));
  return 0.5f * x * (1.f + th);
}
DEVI void item_cmp1(const Params& p, int i, char* smem) {
  char* big = p.ws + OFF_BIG;
  const int lane = TID() & 63, w = TID() >> 6, wm = w >> 1, wn = w & 1;
  const int kv = i >> 5, bh = (i >> 2) & 7, mt = i & 3, b = bh >> 1, hkv = bh & 1;
  const bf16_t* A = (const bf16_t*)(big + (kv ? B_NVC : B_NKC)) + ((size_t)b * SEQ + 16 * (mt * 128)) * 128 + hkv * 64;
  const bf16_t* Bt = (const bf16_t*)(p.ws + OFF_W + W_C1) + (size_t)kv * 128 * 2048;
  f32x16 acc[2][2]; zero_acc(acc);
  gemm_core(acc, A, 2048, 128, Bt, 2048, 32, smem);
  const float* cb = (const float*)(p.ws + OFF_MISC + MISC_CBIAS) + kv * 32 * 128;
  bf16_t* hdn = (bf16_t*)(big + B_HDN) + ((size_t)(kv * 8 + bh) * 512) * 128;
#pragma unroll
  for (int mi = 0; mi < 2; ++mi)
#pragma unroll
    for (int ni = 0; ni < 2; ++ni) {
      const int col = wn * 64 + ni * 32 + (lane & 31); float bias = 0.f;
#pragma unroll 8
      for (int ch = 0; ch < 32; ++ch) bias += cb[ch * 128 + col];
      f32x16 a = acc[mi][ni];
#pragma unroll
      for (int reg = 0; reg < 16; ++reg) a[reg] = gelu_tanh(a[reg] + bias);
      st_rm(hdn + wn * 64 + ni * 32, 128, mt * 128 + wm * 64 + mi * 32, a, lane);
    }
}
DEVI void item_cmp2(const Params& p, int i, char* smem) {
  char* big = p.ws + OFF_BIG;
  const int lane = TID() & 63, w = TID() >> 6, wm = w >> 1, wn = w & 1;
  const int kv = i >> 5, mt = i & 31;
  const bf16_t* A = (const bf16_t*)(big + B_HDN) + ((size_t)kv * 4096 + mt * 128) * 128;
  const bf16_t* Bt = (const bf16_t*)(p.ws + OFF_W + W_C2) + (size_t)kv * 128 * 128;
  f32x16 acc[2][2]; zero_acc(acc);
  gemm_core(acc, A, 128, 64, Bt, 128, 2, smem, kv == 0);
  if (wn == 0) {
#pragma unroll
    for (int mi = 0; mi < 2; ++mi)
#pragma unroll
      for (int ni = 0; ni < 2; ++ni) {
        const int row0 = mt * 128 + wm * 64 + mi * 32;
        if (kv == 0) st_rm_s((bf16_t*)(big + B_KCMP) + ni * 32, 64, row0, acc[mi][ni], lane);
        else { const int bh = row0 >> 9; st_tr((bf16_t*)(big + B_VCMPT) + ((size_t)bh * 64 + ni * 32) * 512, 512, row0 & 511, acc[mi][ni], lane); }
      }
  }
}

DEVI void phase_merge(const Params& p, char* smem, bool rev) {
  char* big = p.ws + OFF_BIG;
  const bf16_t* u = (const bf16_t*)(p.ws + OFF_XN);
  const bf16_t* wg = (const bf16_t*)(p.ws + OFF_W + W_G);
  const bf16_t* wb = (const bf16_t*)(p.ws + OFF_W + W_B);
  bf16_t* merged = (bf16_t*)(big + B_MERGED);
  const int NT = 8, ntiles = 128 * NT, lb = logical_block(), G = gridDim.x;
  const int ntl = lb < ntiles ? (ntiles - lb + G - 1) / G : 0;
  auto segfn = [&](int j) {
    int mt, nt; tile_mn(lb + (j >> 3) * G, NT, mt, nt, rev);
    const int sub = j & 7, i = sub >> 1; GSeg2 g; g.swp = true;
    if (!(sub & 1)) { g.A = u + (size_t)mt * 256 * DM; g.lda = DM; g.Bt = wg + ((size_t)i * DM + nt * 128) * DM; g.ldb = DM; g.nk2 = 16; }
    else { const size_t yoff = (i == 0) ? B_QN : (i == 1) ? B_SQ : (i == 2) ? B_NQ : B_DQ;
           g.A = (const bf16_t*)(big + yoff) + (size_t)mt * 256 * 512; g.lda = 512; g.Bt = wb + ((size_t)i * DM + nt * 128) * 512; g.ldb = 512; g.nk2 = 8; }
    return g; };
  auto epi = [&](int j, f32x16 (&acc)[4][2]) {
    const int sub = j & 7, t2 = TID();
    unsigned* gsc = (unsigned*)(big + B_DK) + (size_t)blockIdx.x * 16384 + t2;
    if (!(sub & 1)) {
#pragma unroll
      for (int mi = 0; mi < 4; ++mi)
#pragma unroll
        for (int ni = 0; ni < 2; ++ni)
#pragma unroll
          for (int r = 0; r < 8; ++r) gsc[((mi * 2 + ni) * 8 + r) * 256] = pk2(sigm(acc[mi][ni][2 * r]), sigm(acc[mi][ni][2 * r + 1]));
      return;
    }
    int mt, nt; tile_mn(lb + (j >> 3) * G, NT, mt, nt, rev);
    const int lane = t2 & 63, w = t2 >> 6, wm = w >> 1, wn = w & 1;
#pragma unroll
    for (int mi = 0; mi < 4; ++mi)
#pragma unroll
      for (int ni = 0; ni < 2; ++ni) {
        bf16_t* rp = merged + ((long)mt * 256 + wm * 128 + mi * 32 + (lane & 31)) * DM + nt * 128 + wn * 64 + ni * 32 + 4 * (lane >> 5);
#pragma unroll
        for (int t = 0; t < 4; ++t) {
          const unsigned g0 = gsc[((mi * 2 + ni) * 8 + 2 * t) * 256], g1 = gsc[((mi * 2 + ni) * 8 + 2 * t + 1) * 256];
          float v0 = __uint_as_float(g0 << 16) * acc[mi][ni][4 * t], v1 = __uint_as_float(g0 & 0xffff0000u) * acc[mi][ni][4 * t + 1];
          float v2 = __uint_as_float(g1 << 16) * acc[mi][ni][4 * t + 2], v3 = __uint_as_float(g1 & 0xffff0000u) * acc[mi][ni][4 * t + 3];
          if (sub != 1) {
            const u32x2 o = *(const u32x2*)(rp + 8 * t);
            v0 += __uint_as_float(o.x << 16); v1 += __uint_as_float(o.x & 0xffff0000u); v2 += __uint_as_float(o.y << 16); v3 += __uint_as_float(o.y & 0xffff0000u);
          }
          u32x2 v; v.x = pk2(v0, v1); v.y = pk2(v2, v3); *(u32x2*)(rp + 8 * t) = v;
        }
      }
  };
  gemm_stream2(ntl * 8, segfn, epi, smem);
}

DEVI unsigned xb_ld(unsigned* p) { return __hip_atomic_load(p, __ATOMIC_RELAXED, __HIP_MEMORY_SCOPE_AGENT); }
DEVI unsigned xb_add(unsigned* p, unsigned v) { return __hip_atomic_fetch_add(p, v, __ATOMIC_RELAXED, __HIP_MEMORY_SCOPE_AGENT); }
DEVI unsigned xb_xcc_id() { return (unsigned)__builtin_amdgcn_s_getreg((3 << 11) | 20) & 0xFu; }
DEVI void xb_census_post(unsigned* bar, char* smem) {
  if (TID() == 0) { volatile unsigned* st = (volatile unsigned*)(smem + SMEM_BYTES - 12); const unsigned x = xb_xcc_id(); st[2] = x; st[0] = 0; st[1] = 0; (void)xb_add(&bar[64 * x], 1u); }
}
DEVI void xb_census_complete(unsigned* bar, char* smem) {
  if (TID() == 0) {
    volatile unsigned* st = (volatile unsigned*)(smem + SMEM_BYTES - 12);
    const unsigned x = st[2], G = gridDim.x;
    unsigned mine = 0, cnt = 0, sum = 0, sp = 0;
    for (;;) {
      sum = 0; cnt = 0; mine = 0;
      for (unsigned j = 0; j < 16; ++j) { const unsigned c = xb_ld(&bar[64 * j]); sum += c; cnt += (c > 0u) ? 1u : 0u; mine = (j == x) ? c : mine; }
      if (sum == G || ++sp > (1u << 22)) break;
      __builtin_amdgcn_s_sleep(1);
    }
    st[0] = mine > 0u ? mine : 1u; st[1] = cnt > 0u ? cnt : 1u;
  }
  __syncthreads();
}
DEVI void xb_barrier(unsigned* bar, char* smem) {
  asm volatile("s_waitcnt vmcnt(0)" ::: "memory");
  __syncthreads();
  if (TID() == 0) {
    asm volatile("s_waitcnt vmcnt(0) lgkmcnt(0)" ::: "memory");
    volatile unsigned* st = (volatile unsigned*)(smem + SMEM_BYTES - 12);
    const unsigned nloc = st[0], nx = st[1], x = st[2];
    const unsigned old = xb_add(&bar[1024 + 64 * x], 1u), gen = old / nloc;
    if (old + 1u == (gen + 1u) * nloc) {
      __builtin_amdgcn_fence(__ATOMIC_RELEASE, "agent");
      asm volatile("s_waitcnt vmcnt(0)" ::: "memory");
      const unsigned og = xb_add(&bar[3072], 1u), tg = og / nx;
      if (og + 1u == (tg + 1u) * nx) xb_add(&bar[3136], 1u);
      else { unsigned sp = 0; while (xb_ld(&bar[3136]) == tg && ++sp < (1u << 24)) __builtin_amdgcn_s_sleep(1); }
      __builtin_amdgcn_fence(__ATOMIC_ACQUIRE, "agent");
      xb_add(&bar[2048 + 64 * x], 1u);
      asm volatile("s_waitcnt vmcnt(0)" ::: "memory");
    } else {
      unsigned sp = 0; while (xb_ld(&bar[2048 + 64 * x]) == gen && ++sp < (1u << 24)) __builtin_amdgcn_s_sleep(1);
      __builtin_amdgcn_fence(__ATOMIC_ACQUIRE, "agent");
      asm volatile("s_waitcnt vmcnt(0)" ::: "memory");
    }
  }
  __syncthreads();
}

DEVI void run_phase(const Params& p_in, int ph, char* smem, int dup = 0) {
  Params p = p_in;
  {
    size_t z = 0; asm volatile("" : "+s"(z));
    p.x += z; p.norm_g += z; p.w_in += z; p.mla_q_norm += z; p.mla_kv_norm += z; p.mla_w_uq += z; p.mla_w_ukv += z; p.swa_sinks += z; p.cmp_pos += z;
    p.cmp_w1 += z; p.cmp_w2 += z; p.diff_lambda += z; p.diff_subln += z; p.rel_bias += z; p.w_branch += z; p.w_gate += z; p.w_o += z; p.ffn_w_gate += z;
    p.ffn_w_up += z; p.ffn_w_down += z; p.final_g += z; p.out += z; p.ws += z;
  }
  char* big = p.ws + OFF_BIG;
  const int xcd = blockIdx.x & 7;
  int* ctr = (int*)(p.ws + OFF_MISC + MISC_CTR) + ((ph + 32 * dup) * 8 + xcd) * 16;
  if (ph == 28) {
    for (int it = logical_block(); it < MTOK / 16; it += gridDim.x) norm_rows(p.out, p.final_g, nullptr, p.out, it);
    return;
  }
  const int l = ph / 14, s = ph % 14;
  const bool rev = (ph & 1) != 0;
#ifdef ONLY
  if (s != ONLY) return;
#endif
#ifdef SKIP_MIXER
  if (s >= 3 && s <= 10) return;
#endif
  switch (s) {
    case 0: phase_norm_conv(p, l, 0, smem, rev); break;
    case 1: phase_ffn_up(p, smem, rev); break;
    case 2: gemm_resid_phase((const bf16_t*)(big + B_ACT), DFF, 44, (const bf16_t*)(p.ws + OFF_W + W_D), l == 0 ? p.x : p.out, p.out, 0.5f, smem, rev); break;
    case 3: phase_norm_conv(p, l, 1, smem, rev); break;
    case 4: phase_win(p, smem, rev); break;
    case 5: {
      for (;;) { const int it = fetch_item(ctr, smem); if (it >= 712) break;
        if (it < 8) item_cmp1(p, xcd * 8 + it, smem); else if (it < 200) item_mla_expand(p, 0, xcd * 192 + it - 8, smem);
        else if (it < 456) item_mla_expand(p, 1, xcd * 256 + it - 200, smem);
        else { const int j = it - 456; item_swa(p, l, xcd >> 1, (xcd & 1) * 4 + (j & 3), 63 - (j >> 2), smem); } }
    } break;
    case 6: {
      for (;;) { const int it = fetch_item(ctr, smem); if (it >= 136) break;
        if (it < 128) { const int pr = 2 * xcd + (it & 1); item_diff(p, l, pr >> 2, pr & 3, 63 - (it >> 1), smem); } else item_cmp2(p, xcd * 8 + it - 128, smem); }
    } break;
    case 7: {
      for (;;) { const int it = fetch_item(ctr, smem); if (it >= 320) break;
        if (it < 64) item_cmp(p, xcd, 63 - it, smem);
        else { const int j = it - 64; item_mla(p, xcd >> 1, (xcd & 1) * 4 + (j & 3), 63 - (j >> 2), smem); } }
    } break;
    case 8: {
      for (;;) { const int it = fetch_item(ctr, smem); if (it >= 256) break; item_selwin(p, xcd >> 1, (xcd & 1) * 4 + (it & 3), 63 - (it >> 2), smem); }
    } break;
    case 9: phase_merge(p, smem, rev); break;
    case 10: gemm_resid_phase((const bf16_t*)(big + B_MERGED), DM, 16, (const bf16_t*)(p.ws + OFF_W + W_O), p.out, p.out, 1.0f, smem, rev); break;
    case 11: phase_norm_conv(p, l, 2, smem, rev); break;
    case 12: phase_ffn_up(p, smem, rev); break;
    case 13: gemm_resid_phase((const bf16_t*)(big + B_ACT), DFF, 44, (const bf16_t*)(p.ws + OFF_W + W_D), p.out, p.out, 0.5f, smem, rev); break;
  }
}

__global__ void __launch_bounds__(256, 2) __attribute__((amdgpu_waves_per_eu(2, 2))) hybrid_fwd(Params p, int ph_lo, int ph_hi) {
  __shared__ __attribute__((aligned(16))) char smem[SMEM_BYTES];
#if ONE_LAUNCH
  cg::grid_group grid = cg::this_grid();
#endif
  int dup = 0;
#if ONE_LAUNCH
  unsigned* bar = (unsigned*)(p.ws + OFF_MISC + MISC_BAR);
  xb_census_post(bar, smem);
  bool first = true;
#endif
  for (int ph = ph_lo; ph < ph_hi; ++ph) {
    run_phase(p, ph, smem, dup);
#if ONE_LAUNCH
    if (ph + 1 < ph_hi) {
      if (first) { xb_census_complete(bar, smem); first = false; }
      xb_barrier(bar, smem);
      if (ph_hi > 1000) grid.sync();
    }
#endif
#ifdef PROBE_DUP_HI
    if (ph < 28 && ph % 14 == PROBE_DUP_HI) { if (!dup) { dup = 1; ph -= (PROBE_DUP_HI - PROBE_DUP_LO + 1); } else dup = 0; }
#endif
  }
}

extern "C" void kernel_launch(void* const* d_in, const int* in_sizes, int n_in, void* d_out, int out_size, void* d_ws, size_t ws_size,
                              hipStream_t stream) {
  (void)in_sizes; (void)n_in; (void)out_size;
  if (ws_size < WS_NEED) { fprintf(stderr, "workspace too small: %zu < %zu\n", ws_size, (size_t)WS_NEED); return; }
  Params p{};
  const float** f = (const float**)&p;
  for (int i = 0; i < 21; ++i) f[i] = (const float*)d_in[i];
  p.out = (float*)d_out; p.ws = (char*)d_ws;
  static int grid_blocks = 0;
  if (!grid_blocks) {
    int dev = 0, cus = 0, per_cu = 0;
    hipGetDevice(&dev);
    hipDeviceGetAttribute(&cus, hipDeviceAttributeMultiprocessorCount, dev);
    hipOccupancyMaxActiveBlocksPerMultiprocessor(&per_cu, hybrid_fwd, 256, 0);
    if (per_cu > 2) per_cu = 2;
    grid_blocks = cus * per_cu;
    grid_blocks -= grid_blocks % 8;
  }
  hipMemsetAsync((char*)d_ws + OFF_MISC + MISC_CTR, 0, MISC_ZERO_BYTES, stream);
#if ONE_LAUNCH
  int lo = 0, hi = NPHASE;
  void* args[] = {&p, &lo, &hi};
  hipError_t e = hipLaunchCooperativeKernel((void*)hybrid_fwd, dim3(grid_blocks), dim3(256), args, 0, stream);
  if (e != hipSuccess) fprintf(stderr, "cooperative launch failed: %s (grid %d)\n", hipGetErrorString(e), grid_blocks);
#else
  for (int ph = 0; ph < NPHASE; ++ph) hipLaunchKernelGGL(hybrid_fwd, dim3(grid_blocks), dim3(256), 0, stream, p, ph, ph + 1);
#endif
}
```
